# Optimizing an MI355X kernel written in HIP

```python
import math
import jax, jax.numpy as jnp
from jax import lax
import numpy as np

D_MODEL = 1024
BATCH = 4
SEQ = 4096
DEPTH = 2

HEAD_DIM = 64
SB_HEADS = 8
SW_HEADS = 8
SW_KV_HEADS = 2
SW_GROUP = SW_HEADS // SW_KV_HEADS
WINDOW = 128
BLOCK = 128
D_FF = 4 * D_MODEL
PLE_DIM = 256
N_BUCKETS = 32
MAX_DISTANCE = 128
EPS = 1e-6

SB_W = SB_HEADS * HEAD_DIM
SW_QW = SW_HEADS * HEAD_DIM
SW_KVW = SW_KV_HEADS * HEAD_DIM
IN_COLS = 3 * SB_W + SW_QW + 2 * SW_KVW + 2 * D_MODEL

kernel_name = "stick_breaking_swa_sink_hybrid_block"


def rmsnorm(x, g):
    xf = x.astype(jnp.float32)
    r = lax.rsqrt(jnp.mean(xf * xf, axis=-1, keepdims=True) + EPS)
    return (xf * r).astype(x.dtype) * g


def t5_causal_bucket(dist):
    max_exact = N_BUCKETS // 2
    d = jnp.maximum(dist, 0)
    df = jnp.maximum(d, 1).astype(jnp.float32)
    large = max_exact + (jnp.log(df / max_exact) / math.log(MAX_DISTANCE / max_exact)
                         * (N_BUCKETS - max_exact)).astype(jnp.int32)
    large = jnp.minimum(large, N_BUCKETS - 1)
    return jnp.where(d < max_exact, d, large)


def stick_breaking_attention(q, k, v):
    b_, s_, h_, dh = q.shape
    nb = s_ // BLOCK
    scale = dh ** -0.5
    qb = q.reshape(b_, nb, BLOCK, h_, dh).transpose(1, 0, 3, 2, 4)
    kpos = jnp.arange(s_)

    def one_block(args):
        qblk, n = args
        z = jnp.einsum('bhqd,bshd->bhqs', qblk, k).astype(jnp.float32) * scale
        qpos = n * BLOCK + jnp.arange(BLOCK)
        causal = kpos[None, :] < qpos[:, None]
        log_beta = jax.nn.log_sigmoid(z)
        log_1mb = jnp.where(causal, jax.nn.log_sigmoid(-z), 0.0)
        suffix = lax.cumsum(log_1mb, axis=3, reverse=True) - log_1mb
        a = jnp.where(causal, jnp.exp(log_beta + suffix), 0.0)
        return jnp.einsum('bhqs,bshd->bqhd', a.astype(v.dtype), v)

    o = lax.map(one_block, (qb, jnp.arange(nb)))
    return o.transpose(1, 0, 2, 3, 4).reshape(b_, s_, h_ * dh)


def sliding_window_sink_attention(q, k, v, sinks, bias):
    b_, s_ = q.shape[:2]
    nb = s_ // BLOCK
    scale = HEAD_DIM ** -0.5
    qb = q.reshape(b_, nb, BLOCK, SW_KV_HEADS, SW_GROUP, HEAD_DIM)
    pad = jnp.zeros((b_, BLOCK, SW_KV_HEADS, HEAD_DIM), k.dtype)
    kp = jnp.concatenate([pad, k], axis=1).reshape(b_, nb + 1, BLOCK, SW_KV_HEADS, HEAD_DIM)
    vp = jnp.concatenate([pad, v], axis=1).reshape(b_, nb + 1, BLOCK, SW_KV_HEADS, HEAD_DIM)
    kb = jnp.concatenate([kp[:, :-1], kp[:, 1:]], axis=2)
    vb = jnp.concatenate([vp[:, :-1], vp[:, 1:]], axis=2)
    s = jnp.einsum('bnqkgd,bnskd->bnkgqs', qb, kb).astype(jnp.float32) * scale + bias
    i = jnp.arange(BLOCK)[:, None]
    j = jnp.arange(2 * BLOCK)[None, :]
    dist = BLOCK + i - j
    band = (dist >= 0) & (dist < WINDOW)
    key_abs = (jnp.arange(nb)[:, None, None] - 1) * BLOCK + j[None]
    valid = band[None] & (key_abs >= 0)
    s = jnp.where(valid[None, :, None, None], s, -jnp.inf)
    sink = sinks.astype(jnp.float32).reshape(SW_KV_HEADS, SW_GROUP)[None, None, :, :, None, None]
    m = jnp.maximum(jnp.max(s, axis=-1, keepdims=True), sink)
    e = jnp.exp(s - m)
    denom = jnp.sum(e, axis=-1, keepdims=True) + jnp.exp(sink - m)
    pr = (e / denom).astype(v.dtype)
    o = jnp.einsum('bnkgqs,bnskd->bnqkgd', pr, vb)
    return o.reshape(b_, s_, SW_HEADS * HEAD_DIM)


def window_bias(rel_bias):
    i = jnp.arange(BLOCK)[:, None]
    j = jnp.arange(2 * BLOCK)[None, :]
    dist = BLOCK + i - j
    bias = rel_bias[t5_causal_bucket(dist)]
    return bias.transpose(2, 0, 1).reshape(SW_KV_HEADS, SW_GROUP, BLOCK, 2 * BLOCK)


def setup_inputs(seed: int = 0) -> dict:
    key = jax.random.key(seed)
    ks = jax.random.split(key, 20)
    f32 = jnp.float32

    def nrm(k, shape, fan_in):
        return jax.random.normal(k, shape, f32) * (fan_in ** -0.5)

    return {
        "x": jax.random.normal(ks[0], (BATCH, SEQ, D_MODEL), f32),
        "p": jax.random.normal(ks[1], (DEPTH, BATCH, SEQ, PLE_DIM), f32),
        "w_in": nrm(ks[2], (DEPTH, D_MODEL, IN_COLS), D_MODEL),
        "w_up_a": nrm(ks[3], (DEPTH, SB_W, D_MODEL), SB_W),
        "w_up_b": nrm(ks[4], (DEPTH, SW_QW, D_MODEL), SW_QW),
        "w_o": nrm(ks[5], (DEPTH, D_MODEL, D_MODEL), D_MODEL),
        "w_ff1": nrm(ks[6], (DEPTH, D_MODEL, D_FF), D_MODEL),
        "w_ff2": nrm(ks[7], (DEPTH, D_FF, D_MODEL), D_FF),
        "w_pe": nrm(ks[8], (DEPTH, PLE_DIM, D_MODEL), PLE_DIM),
        "w_pg": nrm(ks[9], (DEPTH, D_MODEL, D_MODEL), D_MODEL),
        "g_mix": 1.0 + 0.01 * jax.random.normal(ks[10], (DEPTH, D_MODEL), f32),
        "g_mlp": 1.0 + 0.01 * jax.random.normal(ks[11], (DEPTH, D_MODEL), f32),
        "g_pe": 1.0 + 0.01 * jax.random.normal(ks[12], (DEPTH, D_MODEL), f32),
        "g_final": 1.0 + 0.01 * jax.random.normal(ks[13], (D_MODEL,), f32),
        "sinks": 0.5 * jax.random.normal(ks[14], (DEPTH, SW_HEADS), f32),
        "rel_bias": 0.5 * jax.random.normal(ks[15], (N_BUCKETS, SW_HEADS), f32),
    }


def reference(x, p, w_in, w_up_a, w_up_b, w_o, w_ff1, w_ff2, w_pe, w_pg,
              g_mix, g_mlp, g_pe, g_final, sinks, rel_bias):
    b_, s_, _ = x.shape
    bias = window_bias(rel_bias)
    o1 = SB_W
    o2 = o1 + SB_W
    o3 = o2 + SB_W
    o4 = o3 + SW_QW
    o5 = o4 + SW_KVW
    o6 = o5 + SW_KVW
    o7 = o6 + D_MODEL
    for i in range(DEPTH):
        h = rmsnorm(x, g_mix[i])
        proj = h @ w_in[i]
        q_a = proj[..., :o1].reshape(b_, s_, SB_HEADS, HEAD_DIM)
        k_a = proj[..., o1:o2].reshape(b_, s_, SB_HEADS, HEAD_DIM)
        v_a = proj[..., o2:o3].reshape(b_, s_, SB_HEADS, HEAD_DIM)
        q_b = proj[..., o3:o4].reshape(b_, s_, SW_HEADS, HEAD_DIM)
        k_b = proj[..., o4:o5].reshape(b_, s_, SW_KV_HEADS, HEAD_DIM)
        v_b = proj[..., o5:o6].reshape(b_, s_, SW_KV_HEADS, HEAD_DIM)
        gate_a = proj[..., o6:o7]
        gate_b = proj[..., o7:]
        y_a = stick_breaking_attention(q_a, k_a, v_a) @ w_up_a[i]
        y_b = sliding_window_sink_attention(q_b, k_b, v_b, sinks[i], bias) @ w_up_b[i]
        merged = jax.nn.sigmoid(gate_a) * y_a + jax.nn.sigmoid(gate_b) * y_b
        x = x + merged @ w_o[i]
        h = rmsnorm(x, g_mlp[i])
        x = x + jnp.square(jax.nn.relu(h @ w_ff1[i])) @ w_ff2[i]
        pe = p[i] @ w_pe[i]
        x = x + pe * jax.nn.sigmoid(rmsnorm(x, g_pe[i]) @ w_pg[i])
    return rmsnorm(x, g_final)
```

```cpp
#include <hip/hip_runtime.h>
#include <cstdio>
#include <cstdint>

typedef unsigned short bf16;
typedef short bf16x8 __attribute__((ext_vector_type(8)));
typedef float f32x4 __attribute__((ext_vector_type(4)));
typedef unsigned u32x4 __attribute__((ext_vector_type(4)));
typedef unsigned u32x2 __attribute__((ext_vector_type(2)));

constexpr int BATCH = 4, SEQ = 4096, D = 1024, DEPTH = 2, HD = 64;
constexpr int M = BATCH * SEQ;
constexpr int NIN = 4352, FF = 4096, PLE = 256;
constexpr int NQKV = 2304, NGATE = 2048;
constexpr float EPS = 1e-6f;
constexpr float LOG2E = 1.4426950408889634f;
constexpr float C2 = 0.125f * LOG2E;

constexpr size_t MiB = 1u << 20;
constexpr size_t WS_CTL = 0;
constexpr size_t WS_WIN = 1 * MiB;
constexpr size_t WS_WUP = WS_WIN + (size_t)NIN * D * 2;
constexpr size_t WS_WO = WS_WUP + 2 * MiB;
constexpr size_t WS_WFF1 = WS_WO + 2 * MiB;
constexpr size_t WS_WFF2 = WS_WFF1 + 8 * MiB;
constexpr size_t WS_WPE = WS_WFF2 + 8 * MiB;
constexpr size_t WS_WPG = WS_WPE + MiB / 2;
constexpr size_t WS_SS = 32 * MiB;
constexpr size_t WS_BT = 33 * MiB;
constexpr size_t WS_PB = 34 * MiB;
constexpr size_t WS_XB = 50 * MiB;
constexpr size_t WS_ATT = 82 * MiB;
constexpr size_t WS_QKV = 114 * MiB;
constexpr size_t WS_GATE = 186 * MiB;
constexpr size_t WS_MRG = WS_QKV;
constexpr size_t WS_U = WS_QKV;
constexpr size_t WS_PE = WS_ATT;
constexpr size_t WS_END = 250 * MiB;
static_assert(WS_WPG + 2 * MiB <= WS_SS && WS_U + (size_t)M * FF * 2 <= WS_END && WS_GATE + (size_t)M * NGATE * 2 <= WS_END, "ws map");

__device__ __forceinline__ unsigned f2bf(float f) { unsigned u = __builtin_bit_cast(unsigned, f); return (u + 0x7fffu + ((u >> 16) & 1u)) >> 16; }
__device__ __forceinline__ unsigned pk2(float lo, float hi) { return f2bf(lo) | (f2bf(hi) << 16); }
__device__ __forceinline__ float bf2f(unsigned short b) { return __builtin_bit_cast(float, (unsigned)b << 16); }
__device__ __forceinline__ float sigmoidf_(float v) { return 1.0f / (1.0f + __expf(-v)); }
__device__ __forceinline__ float wave_sum(float v) {
#pragma unroll
    for (int o = 1; o < 64; o <<= 1) v += __shfl_xor(v, o);
    return v;
}
__device__ __forceinline__ float row_rs(const float* SS, int row) {
    const f32x4* p = (const f32x4*)(SS + (size_t)row * 16);
    f32x4 a = p[0], b = p[1], c = p[2], d = p[3];
    f32x4 s = (a + b) + (c + d);
    return 1.0f / sqrtf(((s[0] + s[1]) + (s[2] + s[3])) * (1.0f / D) + EPS);
}

__global__ void __launch_bounds__(256) k_conv_w(const float* W, const float* g, bf16* WT, int K, int N, int ldk, int koff) {
    __shared__ float scr_all[4][64 * 33];
    const int lane = threadIdx.x & 63, wave = threadIdx.x >> 6;
    float* scr = scr_all[wave];
    const int nblk = N / 32, nitems = (K / 64) * nblk;
    for (int item = blockIdx.x * 4 + wave; item < nitems; item += gridDim.x * 4) {
        const int kb = item / nblk, nb = item % nblk, k0 = 64 * kb, n0 = 32 * nb;
#pragma unroll 8
        for (int i = 0; i < 32; ++i) { const int kk = 2 * i + (lane >> 5); const float gs = g ? g[k0 + kk] : 1.0f; scr[kk * 33 + (lane & 31)] = W[(size_t)(k0 + kk) * N + n0 + (lane & 31)] * gs; }
        asm volatile("s_waitcnt lgkmcnt(0)" ::: "memory");
        const int c = lane & 7;
#pragma unroll
        for (int j = 0; j < 4; ++j) { const int n = (lane >> 3) + 8 * j; const float* s = scr + (8 * c) * 33 + n;
            u32x4 o; o.x = pk2(s[0 * 33], s[1 * 33]); o.y = pk2(s[2 * 33], s[3 * 33]); o.z = pk2(s[4 * 33], s[5 * 33]); o.w = pk2(s[6 * 33], s[7 * 33]);
            *(u32x4*)(WT + (size_t)(n0 + n) * ldk + koff + k0 + 8 * c) = o; }
        asm volatile("s_waitcnt lgkmcnt(0)" ::: "memory");
    }
}
__global__ void __launch_bounds__(256) k_conv_act(const float* src, bf16* dst, size_t n4) {
    for (size_t i = (size_t)blockIdx.x * 256 + threadIdx.x; i < n4; i += (size_t)gridDim.x * 256) {
        const f32x4 v = ((const f32x4*)src)[i]; u32x2 o; o.x = pk2(v[0], v[1]); o.y = pk2(v[2], v[3]); ((u32x2*)dst)[i] = o; }
}
__global__ void __launch_bounds__(256) k_rownorm(const float* x, bf16* XB, float* SS) {
    const int lane = threadIdx.x & 63, row = blockIdx.x * 4 + (threadIdx.x >> 6);
    const f32x4* xr = (const f32x4*)(x + (size_t)row * D) + lane;
    float s = 0.f; u32x2* o = (u32x2*)(XB + (size_t)row * D) + lane;
#pragma unroll
    for (int j = 0; j < 4; ++j) { const f32x4 v = xr[64 * j]; s += (v[0] * v[0] + v[1] * v[1]) + (v[2] * v[2] + v[3] * v[3]); u32x2 w; w.x = pk2(v[0], v[1]); w.y = pk2(v[2], v[3]); o[64 * j] = w; }
    s = wave_sum(s);
    if (lane < 16) SS[(size_t)row * 16 + lane] = lane == 0 ? s : 0.f;
}
__device__ __forceinline__ int t5_bucket(int d) {
    if (d < 16) return d;
    const float df = (float)d;
    int large = 16 + (int)(logf(df / 16.0f) / 2.0794415416798357f * 16.0f);
    return large < 31 ? large : 31;
}
__global__ void k_bias_table(const float* rel_bias, const float* sinks, float* BT) {
    const int i = threadIdx.x + blockIdx.x * blockDim.x;
    if (i < 8 * 128) { const int h = i >> 7, d = i & 127; BT[i] = rel_bias[t5_bucket(d) * 8 + h] * LOG2E; }
    if (i < 16) BT[1024 + i] = sinks[i] * LOG2E;
}

template <class Epi>
__global__ void __launch_bounds__(256) k_gemm(const bf16* A, int lda, const bf16* Bt, int ldb, int K, int ksplit, Epi E) {
    const int lane = threadIdx.x & 63, wave = threadIdx.x >> 6, fr = lane & 15, fq = lane >> 4;
    const int row0 = blockIdx.y * 64 + (wave >> 1) * 32, col0 = blockIdx.x * 64 + (wave & 1) * 32;
    f32x4 va[2][2], vb[2][2];
#pragma unroll
    for (int i = 0; i < 2; ++i)
#pragma unroll
        for (int j = 0; j < 2; ++j) { va[i][j] = (f32x4){0.f, 0.f, 0.f, 0.f}; vb[i][j] = (f32x4){0.f, 0.f, 0.f, 0.f}; }
    const bf16* ap = A + (size_t)(row0 + fr) * lda + fq * 8;
    const bf16* bp = Bt + (size_t)(col0 + fr) * ldb + fq * 8;
    for (int k0 = 0; k0 < K; k0 += 32) {
        bf16x8 a[2], b[2];
#pragma unroll
        for (int i = 0; i < 2; ++i) { a[i] = *(const bf16x8*)(ap + (size_t)i * 16 * lda + k0); b[i] = *(const bf16x8*)(bp + (size_t)i * 16 * ldb + k0); }
        if (k0 < ksplit) {
#pragma unroll
            for (int i = 0; i < 2; ++i)
#pragma unroll
                for (int j = 0; j < 2; ++j) va[i][j] = __builtin_amdgcn_mfma_f32_16x16x32_bf16(b[j], a[i], va[i][j], 0, 0, 0);
        } else {
#pragma unroll
            for (int i = 0; i < 2; ++i)
#pragma unroll
                for (int j = 0; j < 2; ++j) vb[i][j] = __builtin_amdgcn_mfma_f32_16x16x32_bf16(b[j], a[i], vb[i][j], 0, 0, 0);
        }
    }
#pragma unroll
    for (int i = 0; i < 2; ++i)
#pragma unroll
        for (int j = 0; j < 2; ++j) E.apply(row0 + i * 16 + fr, col0 + j * 16 + 4 * fq, va[i][j], vb[i][j]);
}

__device__ __forceinline__ void store_bf16x4(bf16* p, f32x4 v) { u32x2 w; w.x = pk2(v[0], v[1]); w.y = pk2(v[2], v[3]); *(u32x2*)p = w; }
__device__ __forceinline__ f32x4 load_bf16x4(const bf16* p) { const u32x2 w = *(const u32x2*)p; return (f32x4){__builtin_bit_cast(float, w.x << 16), __builtin_bit_cast(float, w.x & 0xffff0000u), __builtin_bit_cast(float, w.y << 16), __builtin_bit_cast(float, w.y & 0xffff0000u)}; }

struct EpiIn { const float* SS; bf16* QKV; bf16* GATE;
    __device__ __forceinline__ void apply(int row, int col, f32x4 v, f32x4) const {
        const float r = row_rs(SS, row); v = v * r;
        if (col < NQKV) { if (col < 512 || (col >= 1536 && col < 2048)) v = v * C2; store_bf16x4(QKV + (size_t)row * NQKV + col, v); }
        else { f32x4 s; s[0] = sigmoidf_(v[0]); s[1] = sigmoidf_(v[1]); s[2] = sigmoidf_(v[2]); s[3] = sigmoidf_(v[3]); store_bf16x4(GATE + (size_t)row * NGATE + (col - NQKV), s); }
    } };
struct EpiUp { const bf16* GATE; bf16* MRG;
    __device__ __forceinline__ void apply(int row, int col, f32x4 va, f32x4 vb) const {
        const f32x4 ga = load_bf16x4(GATE + (size_t)row * NGATE + col), gb = load_bf16x4(GATE + (size_t)row * NGATE + 1024 + col);
        store_bf16x4(MRG + (size_t)row * D + col, ga * va + gb * vb);
    } };
struct EpiRes { const float* xin; float* xout;
    __device__ __forceinline__ void apply(int row, int col, f32x4 v, f32x4) const {
        const size_t o = (size_t)row * D + col; *(f32x4*)(xout + o) = *(const f32x4*)(xin + o) + v;
    } };
struct EpiFf1 { const float* SS; bf16* U;
    __device__ __forceinline__ void apply(int row, int col, f32x4 v, f32x4) const {
        const float r = row_rs(SS, row); v = v * r;
#pragma unroll
        for (int i = 0; i < 4; ++i) { const float t = fmaxf(v[i], 0.f); v[i] = t * t; }
        store_bf16x4(U + (size_t)row * FF + col, v);
    } };
struct EpiPe { bf16* PE;
    __device__ __forceinline__ void apply(int row, int col, f32x4 v, f32x4) const { store_bf16x4(PE + (size_t)row * D + col, v); } };
struct EpiPg { const float* SS; const bf16* PE; float* x;
    __device__ __forceinline__ void apply(int row, int col, f32x4 v, f32x4) const {
        const float r = row_rs(SS, row); const size_t o = (size_t)row * D + col; const f32x4 pe = load_bf16x4(PE + o); f32x4 xv = *(const f32x4*)(x + o);
#pragma unroll
        for (int i = 0; i < 4; ++i) xv[i] += pe[i] * sigmoidf_(v[i] * r);
        *(f32x4*)(x + o) = xv;
    } };


__device__ __forceinline__ float dot64(const float (&q)[64], const bf16* kp) {
    float y = 0.f;
#pragma unroll
    for (int c = 0; c < 8; ++c) { const u32x4 w = ((const u32x4*)kp)[c];
#pragma unroll
        for (int e = 0; e < 4; ++e) { y += q[c * 8 + 2 * e] * __builtin_bit_cast(float, w[e] << 16); y += q[c * 8 + 2 * e + 1] * __builtin_bit_cast(float, w[e] & 0xffff0000u); } }
    return y;
}
__device__ __forceinline__ void axpy64(float (&o)[64], float a, const bf16* vp) {
#pragma unroll
    for (int c = 0; c < 8; ++c) { const u32x4 w = ((const u32x4*)vp)[c];
#pragma unroll
        for (int e = 0; e < 4; ++e) { o[c * 8 + 2 * e] += a * __builtin_bit_cast(float, w[e] << 16); o[c * 8 + 2 * e + 1] += a * __builtin_bit_cast(float, w[e] & 0xffff0000u); } }
}
__global__ void __launch_bounds__(64) k_sb_naive(const bf16* QKV, bf16* ATT) {
    const int lane = threadIdx.x, blk = blockIdx.x;
    const int tb = blk & 63, h = (blk >> 6) & 7, b = blk >> 9;
    const int t = tb * 64 + lane;
    const bf16* base = QKV + (size_t)b * SEQ * NQKV;
    float q[64], o[64];
    { const bf16* qp = base + (size_t)t * NQKV + h * 64;
#pragma unroll
      for (int d = 0; d < 64; ++d) { q[d] = bf2f(qp[d]); o[d] = 0.f; } }
    float suffix = 0.f;
    for (int s = tb * 64 + 62; s >= 0; --s) {
        const bf16* kp = base + (size_t)s * NQKV + 512 + h * 64; const bf16* vp = base + (size_t)s * NQKV + 1024 + h * 64;
        const float y = dot64(q, kp);
        const float L = log2f(1.0f + exp2f(-fabsf(y)));
        const float lb = fminf(y, 0.f) - L, l1 = fminf(-y, 0.f) - L;
        if (s < t) {
            const float a = bf2f((unsigned short)f2bf(exp2f(lb + suffix)));
            axpy64(o, a, vp);
            suffix += l1;
        }
    }
    bf16* op = ATT + ((size_t)b * SEQ + t) * D + h * 64;
#pragma unroll
    for (int d = 0; d < 64; ++d) op[d] = (bf16)f2bf(o[d]);
}
__global__ void __launch_bounds__(64) k_swa_naive(const bf16* QKV, const float* BT, int layer, bf16* ATT) {
    const int lane = threadIdx.x, blk = blockIdx.x;
    const int tb = blk & 63, h = (blk >> 6) & 7, b = blk >> 9, kvh = h >> 2;
    const int t = tb * 64 + lane;
    const bf16* base = QKV + (size_t)b * SEQ * NQKV;
    const float* bt = BT + h * 128; const float sink = BT[1024 + layer * 8 + h];
    float q[64], o[64];
    { const bf16* qp = base + (size_t)t * NQKV + 1536 + h * 64;
#pragma unroll
      for (int d = 0; d < 64; ++d) { q[d] = bf2f(qp[d]); o[d] = 0.f; } }
    const int s_lo = tb * 64 - 127 > 0 ? tb * 64 - 127 : 0, s_hi = tb * 64 + 63;
    float m = sink;
    for (int s = s_lo; s <= s_hi; ++s) {
        const bf16* kp = base + (size_t)s * NQKV + 2048 + kvh * 64;
        const float y = dot64(q, kp);
        const int dist = t - s;
        if (dist >= 0 && dist < 128) m = fmaxf(m, y + bt[dist]);
    }
    float l = 0.f;
    for (int s = s_lo; s <= s_hi; ++s) {
        const bf16* kp = base + (size_t)s * NQKV + 2048 + kvh * 64; const bf16* vp = base + (size_t)s * NQKV + 2176 + kvh * 64;
        const float y = dot64(q, kp);
        const int dist = t - s;
        if (dist >= 0 && dist < 128) {
            const float e = exp2f(y + bt[dist] - m); l += e;
            const float eb = bf2f((unsigned short)f2bf(e));
            axpy64(o, eb, vp);
        }
    }
    l += exp2f(sink - m);
    const float rl = 1.0f / l;
    bf16* op = ATT + ((size_t)b * SEQ + t) * D + 512 + h * 64;
#pragma unroll
    for (int d = 0; d < 64; ++d) op[d] = (bf16)f2bf(o[d] * rl);
}
__global__ void __launch_bounds__(256) k_final(float* x, const float* gf) {
    const int lane = threadIdx.x & 63, row = blockIdx.x * 4 + (threadIdx.x >> 6);
    f32x4* xr = (f32x4*)(x + (size_t)row * D) + lane; const f32x4* g4 = (const f32x4*)gf + lane;
    f32x4 v[4]; float s = 0.f;
#pragma unroll
    for (int j = 0; j < 4; ++j) { v[j] = xr[64 * j]; s += (v[j][0] * v[j][0] + v[j][1] * v[j][1]) + (v[j][2] * v[j][2] + v[j][3] * v[j][3]); }
    const float r = 1.0f / sqrtf(wave_sum(s) * (1.0f / D) + EPS);
#pragma unroll
    for (int j = 0; j < 4; ++j) xr[64 * j] = (v[j] * r) * g4[64 * j];
}

extern "C" void kernel_launch(void* const* d_in, const int* in_sizes, int n_in, void* d_out, int out_size, void* d_ws, size_t ws_size, hipStream_t stream) {
    if (n_in != 16 || in_sizes[0] != M * D || out_size != M * D || ws_size < WS_END) { fprintf(stderr, "kernel_launch: unexpected shapes (n_in %d, in0 %d, out %d, ws %zu)\n", n_in, n_in > 0 ? in_sizes[0] : -1, out_size, ws_size); return; }
    const float* x_in = (const float*)d_in[0]; const float* p_in = (const float*)d_in[1];
    const float* w_in = (const float*)d_in[2]; const float* w_up_a = (const float*)d_in[3]; const float* w_up_b = (const float*)d_in[4];
    const float* w_o = (const float*)d_in[5]; const float* w_ff1 = (const float*)d_in[6]; const float* w_ff2 = (const float*)d_in[7];
    const float* w_pe = (const float*)d_in[8]; const float* w_pg = (const float*)d_in[9];
    const float* g_mix = (const float*)d_in[10]; const float* g_mlp = (const float*)d_in[11]; const float* g_pe = (const float*)d_in[12]; const float* g_final = (const float*)d_in[13];
    const float* sinks = (const float*)d_in[14]; const float* rel_bias = (const float*)d_in[15];
    unsigned char* ws = (unsigned char*)d_ws; float* X = (float*)d_out;
    bf16 *WIN = (bf16*)(ws + WS_WIN), *WUP = (bf16*)(ws + WS_WUP), *WO = (bf16*)(ws + WS_WO), *WFF1 = (bf16*)(ws + WS_WFF1), *WFF2 = (bf16*)(ws + WS_WFF2), *WPE = (bf16*)(ws + WS_WPE), *WPG = (bf16*)(ws + WS_WPG);
    float* SS = (float*)(ws + WS_SS); float* BT = (float*)(ws + WS_BT);
    bf16 *PB = (bf16*)(ws + WS_PB), *XB = (bf16*)(ws + WS_XB), *ATT = (bf16*)(ws + WS_ATT), *QKV = (bf16*)(ws + WS_QKV), *GATE = (bf16*)(ws + WS_GATE), *MRG = (bf16*)(ws + WS_MRG), *U = (bf16*)(ws + WS_U), *PE = (bf16*)(ws + WS_PE);

    k_bias_table<<<4, 256, 0, stream>>>(rel_bias, sinks, BT);
    k_conv_act<<<2048, 256, 0, stream>>>(p_in, PB, (size_t)DEPTH * M * PLE / 4);
    k_rownorm<<<M / 4, 256, 0, stream>>>(x_in, XB, SS);
    for (int l = 0; l < DEPTH; ++l) {
        k_conv_w<<<1024, 256, 0, stream>>>(w_in + (size_t)l * D * NIN, g_mix + l * D, WIN, D, NIN, D, 0);
        k_conv_w<<<512, 256, 0, stream>>>(w_up_a + (size_t)l * 512 * D, nullptr, WUP, 512, D, D, 0);
        k_conv_w<<<512, 256, 0, stream>>>(w_up_b + (size_t)l * 512 * D, nullptr, WUP, 512, D, D, 512);
        k_conv_w<<<512, 256, 0, stream>>>(w_o + (size_t)l * D * D, nullptr, WO, D, D, D, 0);
        k_conv_w<<<1024, 256, 0, stream>>>(w_ff1 + (size_t)l * D * FF, g_mlp + l * D, WFF1, D, FF, D, 0);
        k_conv_w<<<1024, 256, 0, stream>>>(w_ff2 + (size_t)l * FF * D, nullptr, WFF2, FF, D, FF, 0);
        k_conv_w<<<256, 256, 0, stream>>>(w_pe + (size_t)l * PLE * D, nullptr, WPE, PLE, D, PLE, 0);
        k_conv_w<<<512, 256, 0, stream>>>(w_pg + (size_t)l * D * D, g_pe + l * D, WPG, D, D, D, 0);
        const float* xcur = l == 0 ? x_in : X;
        k_gemm<EpiIn><<<dim3(NIN / 64, M / 64), 256, 0, stream>>>(XB, D, WIN, D, D, D, EpiIn{SS, QKV, GATE});
        k_sb_naive<<<BATCH * 8 * 64, 64, 0, stream>>>(QKV, ATT);
        k_swa_naive<<<BATCH * 8 * 64, 64, 0, stream>>>(QKV, BT, l, ATT);
        k_gemm<EpiUp><<<dim3(D / 64, M / 64), 256, 0, stream>>>(ATT, D, WUP, D, D, 512, EpiUp{GATE, MRG});
        k_gemm<EpiRes><<<dim3(D / 64, M / 64), 256, 0, stream>>>(MRG, D, WO, D, D, D, EpiRes{xcur, X});
        k_rownorm<<<M / 4, 256, 0, stream>>>(X, XB, SS);
        k_gemm<EpiFf1><<<dim3(FF / 64, M / 64), 256, 0, stream>>>(XB, D, WFF1, D, D, D, EpiFf1{SS, U});
        k_gemm<EpiPe><<<dim3(D / 64, M / 64), 256, 0, stream>>>(PB + (size_t)l * M * PLE, PLE, WPE, PLE, PLE, PLE, EpiPe{PE});
        k_gemm<EpiRes><<<dim3(D / 64, M / 64), 256, 0, stream>>>(U, FF, WFF2, FF, FF, FF, EpiRes{X, X});
        k_rownorm<<<M / 4, 256, 0, stream>>>(X, XB, SS);
        k_gemm<EpiPg><<<dim3(D / 64, M / 64), 256, 0, stream>>>(XB, D, WPG, D, D, D, EpiPg{SS, PE, X});
        k_rownorm<<<M / 4, 256, 0, stream>>>(X, XB, SS);
    }
    k_final<<<M / 4, 256, 0, stream>>>(X, g_final);
}
```

```cpp
#include <hip/hip_runtime.h>
#include <cstdio>
#include <cstdint>

namespace pg8 {
#define PG8_LAS __attribute__((address_space(3)))
typedef unsigned short bf16_t;
typedef short bf16x8 __attribute__((ext_vector_type(8)));
typedef float f32x4 __attribute__((ext_vector_type(4)));
typedef unsigned u32x4 __attribute__((ext_vector_type(4)));
constexpr int BM = 256, BK = 64, HALF = 128, HTB = HALF * BK * 2  , STAGE_BYTES = 8 * HTB, NXCD = 8, WGM = 8;

__host__ __device__ __forceinline__ int lds_byte(int r, int c) { const int st = (r >> 4) * 2 + (c >> 5), rr = r & 15, cc = c & 31, ob = rr * 64 + cc * 2; return st * 1024 + (ob ^ (((ob >> 9) & 1) << 5)); }
__host__ __device__ __forceinline__ void stage_rc(int b, int& R, int& C) { const int st = b / 1024, sb = b % 1024, swz = sb ^ (((sb >> 9) & 1) << 5); R = (st >> 1) * 16 + swz / 64; C = (st & 1) * 32 + (swz % 64) / 2; }
__host__ __device__ __forceinline__ int perm32(int rho) { const int n = rho >> 4, i = rho & 15; return 8 * (i >> 2) + 4 * n + (i & 3); }

struct Unit { int pm, pn; };
struct Gemm { const bf16_t* A; const bf16_t* Bt; int M, N, K; };

struct StaticOrder {
    int nM, nN, nwg, G, c;
    __host__ __device__ void init(int M, int N, int G_, int c_) { nM = M / BM; nN = N / BM; nwg = nM * nN; G = G_; c = c_; }
    __host__ __device__ bool next(int i, Unit& u) const {
        const long L = (long)i * G + c; if (L >= nwg) return false;
        int wgid = (int)L; { const int q = nwg / NXCD, r = nwg % NXCD, xcd = wgid % NXCD, off = wgid / NXCD; wgid = (xcd < r ? xcd * (q + 1) : r * (q + 1) + (xcd - r) * q) + off; }
        const int nig = WGM * nN, gid = wgid / nig, fm = gid * WGM, gsz = (nM - fm) < WGM ? (nM - fm) : WGM;
        u.pm = fm + ((wgid % nig) % gsz); u.pn = (wgid % nig) / gsz; return true;
    }
    __device__ __forceinline__ void a_ready(const Unit&) const {}
    __device__ __forceinline__ void done(const Unit&) const {}
};

__device__ __forceinline__ unsigned cvt_pk_bf16(float lo, float hi) { unsigned r; asm volatile("v_cvt_pk_bf16_f32 %0, %1, %2" : "=v"(r) : "v"(lo), "v"(hi)); return r; }
template <class Epi, class Sched, bool ALIGN_EPI = false, bool SP2 = false>
__device__ __forceinline__ void gemm_phase(PG8_LAS unsigned char* lds, const Gemm g, const Sched& S, const Epi& E, const int tid_in) {
    int tid_ = tid_in; asm volatile("" : "+v"(tid_));
    const int tid = tid_, wid = __builtin_amdgcn_readfirstlane(tid >> 6), lane = tid & 63, wr = wid >> 2, wc = wid & 3, fr = lane & 15, fq = lane >> 4;
    int K_ = g.K; asm volatile("" : "+s"(K_));
    const int K = K_, nt = K / BK;
    unsigned voffA[2], voffB[2];
#pragma unroll
    for (int i = 0; i < 2; ++i) { int R, C; stage_rc(tid * 16 + i * 8192, R, C); const int Rb = Epi::PERM ? ((R & ~31) + perm32(R & 31)) : R;
        voffA[i] = (unsigned)(R * K + C) * 2u; voffB[i] = (unsigned)(Rb * K + C) * 2u; }
    const size_t kstep = (size_t)(BK * 2);
    const size_t hstep = (size_t)HALF * K * 2;
    const size_t tstep = 2 * hstep;
    const unsigned ldsw = (unsigned)wid * 1024u;
    const int aoff = lds_byte(wr * 64 + fr, fq * 8), boff = lds_byte(wc * 32 + fr, fq * 8);
#define PG8_SA(b, h) (((b) * 2 + (h)) * HTB)
#define PG8_SB(b, h) ((4 + (b) * 2 + (h)) * HTB)
#define PG8_STAGE(bufoff, gbase, voff) do { _Pragma("unroll") for (int _i = 0; _i < 2; ++_i) \
        __builtin_amdgcn_global_load_lds((const unsigned*)((const char*)(gbase) + (voff)[_i]), (PG8_LAS unsigned*)(lds + (bufoff) + ldsw + _i * 8192), 16, 0, 0); } while (0)
#define PG8_LDA(dst, b, h) do { _Pragma("unroll") for (int m = 0; m < 4; ++m) _Pragma("unroll") for (int k = 0; k < 2; ++k) dst[m][k] = *(const PG8_LAS bf16x8*)(lds + PG8_SA(b, h) + aoff + m * 2048 + k * 1024); } while (0)
#define PG8_LDB(dst, b, h) do { _Pragma("unroll") for (int n = 0; n < 2; ++n) _Pragma("unroll") for (int k = 0; k < 2; ++k) dst[n][k] = *(const PG8_LAS bf16x8*)(lds + PG8_SB(b, h) + boff + n * 2048 + k * 1024); } while (0)
#define PG8_MMA(ai, bj, At, Bt) do { __builtin_amdgcn_s_setprio(1); _Pragma("unroll") for (int m = 0; m < 4; ++m) _Pragma("unroll") for (int n = 0; n < 2; ++n) _Pragma("unroll") for (int k = 0; k < 2; ++k) \
        acc[ai][bj][m][n] = __builtin_amdgcn_mfma_f32_16x16x32_bf16(Bt[n][k], At[m][k], acc[ai][bj][m][n], 0, 0, 0); __builtin_amdgcn_s_setprio(0); } while (0)
#define PG8_WAIT_V(n) asm volatile("s_waitcnt vmcnt(" #n ")" ::: "memory")
#define PG8_WAIT_L(n) asm volatile("s_waitcnt lgkmcnt(" #n ")" ::: "memory")
#define PG8_BAR __builtin_amdgcn_s_barrier()
#define PG8_SCHED __builtin_amdgcn_sched_barrier(0)
    Unit cur, nxt; int ui = 0;
    if (!S.next(0, cur)) return;
    f32x4 acc[2][2][4][2];
#pragma unroll
    for (int a = 0; a < 2; ++a)
#pragma unroll
        for (int b = 0; b < 2; ++b)
#pragma unroll
            for (int m = 0; m < 4; ++m)
#pragma unroll
                for (int n = 0; n < 2; ++n) acc[a][b][m][n] = (f32x4){0.f, 0.f, 0.f, 0.f};
    bf16x8 At[4][2], B0[2][2], B1[2][2];
    const char* cA = (const char*)g.A + (size_t)cur.pm * tstep; const char* cB = (const char*)g.Bt + (size_t)cur.pn * tstep;
    S.a_ready(cur);
    if constexpr (SP2) {
        PG8_STAGE(PG8_SB(0, 0), cB, voffB); PG8_STAGE(PG8_SB(0, 1), cB + hstep, voffB); PG8_STAGE(PG8_SA(0, 0), cA, voffA); PG8_STAGE(PG8_SA(0, 1), cA + hstep, voffA);
        if (wr == 1) PG8_BAR;
        PG8_WAIT_V(2); PG8_BAR;
        PG8_STAGE(PG8_SB(1, 0), cB + kstep, voffB); PG8_STAGE(PG8_SA(1, 0), cA + kstep, voffA); PG8_STAGE(PG8_SB(1, 1), cB + hstep + kstep, voffB);
        PG8_WAIT_V(6); PG8_BAR;
    } else {
        PG8_STAGE(PG8_SB(0, 0), cB, voffB); PG8_STAGE(PG8_SA(0, 0), cA, voffA); PG8_STAGE(PG8_SB(0, 1), cB + hstep, voffB); PG8_STAGE(PG8_SA(0, 1), cA + hstep, voffA);
        if (wr == 1) PG8_BAR;
        PG8_WAIT_V(4); PG8_BAR;
        PG8_STAGE(PG8_SB(1, 0), cB + kstep, voffB); PG8_STAGE(PG8_SA(1, 0), cA + kstep, voffA); PG8_STAGE(PG8_SB(1, 1), cB + hstep + kstep, voffB);
        PG8_WAIT_V(6); PG8_BAR;
    }
    for (;;) {
        const bool has_next = S.next(ui + 1, nxt);
        const char* nA = has_next ? (const char*)g.A + (size_t)nxt.pm * tstep : cA; const char* nB = has_next ? (const char*)g.Bt + (size_t)nxt.pn * tstep : cB;
        for (int t = 0; t < nt; t += 2) {
            const bool last = (t == nt - 2);
            if constexpr (Epi::MIDSCALE) { if (t == (nt >> 1)) E.mid(acc, cur, wr, wc, fr, fq); }
            const char* a1 = cA + (size_t)(t + 1) * kstep;
            const char* a2 = last ? nA : cA + (size_t)(t + 2) * kstep; const char* b2 = last ? nB : cB + (size_t)(t + 2) * kstep;
            const char* a3 = a2 + kstep; const char* b3 = b2 + kstep;
            if (last && has_next) S.a_ready(nxt);
            if constexpr (SP2) {
            PG8_LDB(B0, 0, 0); PG8_LDB(B1, 0, 1); PG8_SCHED; PG8_LDA(At, 0, 0); PG8_STAGE(PG8_SA(1, 1), a1 + hstep, voffA);
            PG8_WAIT_V(8); PG8_WAIT_L(0); PG8_BAR; PG8_MMA(0, 0, At, B0); PG8_MMA(0, 1, At, B1); PG8_BAR; PG8_SCHED;
            PG8_LDA(At, 0, 1); PG8_STAGE(PG8_SB(0, 0), b2, voffB); PG8_STAGE(PG8_SB(0, 1), b2 + hstep, voffB); PG8_STAGE(PG8_SA(0, 0), a2, voffA);
            PG8_WAIT_V(8); PG8_WAIT_L(0); PG8_BAR; PG8_MMA(1, 0, At, B0); PG8_MMA(1, 1, At, B1); PG8_BAR; PG8_SCHED;
            PG8_LDB(B0, 1, 0); PG8_LDB(B1, 1, 1); PG8_SCHED; PG8_LDA(At, 1, 0); PG8_STAGE(PG8_SA(0, 1), a2 + hstep, voffA);
            PG8_WAIT_V(8); PG8_WAIT_L(0); PG8_BAR; PG8_MMA(0, 0, At, B0); PG8_MMA(0, 1, At, B1); PG8_BAR; PG8_SCHED;
            PG8_LDA(At, 1, 1); PG8_STAGE(PG8_SB(1, 0), b3, voffB); PG8_STAGE(PG8_SB(1, 1), b3 + hstep, voffB); PG8_STAGE(PG8_SA(1, 0), a3, voffA);
            PG8_WAIT_V(8); PG8_WAIT_L(0); PG8_BAR; PG8_MMA(1, 0, At, B0); PG8_MMA(1, 1, At, B1); PG8_BAR; PG8_SCHED;
            } else {
            PG8_LDB(B0, 0, 0); PG8_SCHED; PG8_LDA(At, 0, 0); PG8_STAGE(PG8_SA(1, 1), a1 + hstep, voffA);
            PG8_WAIT_L(8); PG8_BAR; PG8_WAIT_L(0); PG8_MMA(0, 0, At, B0); PG8_BAR; PG8_SCHED;
            PG8_LDB(B1, 0, 1); PG8_STAGE(PG8_SB(0, 0), b2, voffB);
            PG8_BAR; PG8_WAIT_L(0); PG8_MMA(0, 1, At, B1); PG8_BAR;
            PG8_LDA(At, 0, 1); PG8_STAGE(PG8_SA(0, 0), a2, voffA);
            PG8_BAR; PG8_WAIT_L(0); PG8_MMA(1, 0, At, B0); PG8_BAR; PG8_SCHED;
            PG8_STAGE(PG8_SB(0, 1), b2 + hstep, voffB);
            PG8_WAIT_V(6); PG8_BAR; PG8_MMA(1, 1, At, B1); PG8_BAR;
            PG8_LDB(B0, 1, 0); PG8_SCHED; PG8_LDA(At, 1, 0); PG8_STAGE(PG8_SA(0, 1), a2 + hstep, voffA);
            PG8_WAIT_L(8); PG8_BAR; PG8_WAIT_L(0); PG8_MMA(0, 0, At, B0); PG8_BAR; PG8_SCHED;
            PG8_LDB(B1, 1, 1); PG8_STAGE(PG8_SB(1, 0), b3, voffB);
            PG8_BAR; PG8_WAIT_L(0); PG8_MMA(0, 1, At, B1); PG8_BAR;
            PG8_LDA(At, 1, 1); PG8_STAGE(PG8_SA(1, 0), a3, voffA);
            PG8_BAR; PG8_WAIT_L(0); PG8_MMA(1, 0, At, B0); PG8_BAR; PG8_SCHED;
            PG8_STAGE(PG8_SB(1, 1), b3 + hstep, voffB);
            PG8_WAIT_V(6); PG8_BAR; PG8_MMA(1, 1, At, B1); PG8_BAR;
            }
        }
        if constexpr (ALIGN_EPI) { if (wr == 0) PG8_BAR; }
        if constexpr (!Epi::AFTER_DRAIN) { E(acc, cur, wr, wc, fr, fq); S.done(cur); }
        if (!has_next) break;
#pragma unroll
        for (int a = 0; a < 2; ++a)
#pragma unroll
            for (int b = 0; b < 2; ++b)
#pragma unroll
                for (int m = 0; m < 4; ++m)
#pragma unroll
                    for (int n = 0; n < 2; ++n) acc[a][b][m][n] = (f32x4){0.f, 0.f, 0.f, 0.f};
        cur = nxt; cA = nA; cB = nB; ++ui;
        if constexpr (ALIGN_EPI) { if (wr == 1) PG8_BAR; }
    }
    PG8_WAIT_V(0);
    if constexpr (!ALIGN_EPI) { if (wr == 0) PG8_BAR; }
    PG8_BAR;
    if constexpr (Epi::AFTER_DRAIN) { E.fused(acc, cur, wr, wc, fr, fq, lds, wid, lane); S.done(cur); }
#undef PG8_SA
#undef PG8_SB
#undef PG8_STAGE
#undef PG8_LDA
#undef PG8_LDB
#undef PG8_MMA
#undef PG8_WAIT_V
#undef PG8_WAIT_L
#undef PG8_BAR
#undef PG8_SCHED
}
}


typedef unsigned short bf16;
typedef short bf16x8 __attribute__((ext_vector_type(8)));
typedef float f32x4 __attribute__((ext_vector_type(4)));
typedef unsigned u32x4 __attribute__((ext_vector_type(4)));
typedef unsigned u32x2 __attribute__((ext_vector_type(2)));
#define LAS __attribute__((address_space(3)))
#define GAS __attribute__((address_space(1)))
#define DI __device__ __forceinline__

constexpr int BATCH = 4, SEQ = 4096, D = 1024, DEPTH = 2;
constexpr int M = BATCH * SEQ;
constexpr int NIN = 4352, FF = 4096, PLE = 256;
constexpr int NQKV = 2304, NGATE = 2048;
constexpr float EPS = 1e-6f;
constexpr float LOG2E = 1.4426950408889634f;
constexpr float C2 = 0.125f * LOG2E;
constexpr int NWAVES = 8;

constexpr size_t MiB = 1u << 20;
constexpr size_t WS_CTL = 0, CTL_ZERO_BYTES = 64 * 1024;
constexpr size_t WS_WIN = 1 * MiB;
constexpr size_t WS_WUP = WS_WIN + (size_t)NIN * D * 2;
constexpr size_t WS_WO = WS_WUP + 2 * MiB;
constexpr size_t WS_WFF1 = WS_WO + 2 * MiB;
constexpr size_t WS_WFF2 = WS_WFF1 + 8 * MiB;
constexpr size_t WS_WPE = WS_WFF2 + 8 * MiB;
constexpr size_t WS_WPG = WS_WPE + MiB / 2;
constexpr size_t WS_SS = 32 * MiB;
constexpr size_t WS_BT = 33 * MiB;
constexpr size_t WS_PB = 34 * MiB;
constexpr size_t WS_XB = 50 * MiB;
constexpr size_t WS_ATT = 82 * MiB;
constexpr size_t WS_QKV = 114 * MiB;
constexpr size_t WS_GATE = 186 * MiB;
constexpr size_t WS_MRG = WS_QKV;
constexpr size_t WS_U = WS_QKV;
constexpr size_t WS_PE = WS_ATT;
constexpr size_t WS_END = 250 * MiB;
static_assert(WS_WPG + 2 * MiB <= WS_SS && WS_U + (size_t)M * FF * 2 <= WS_END && WS_GATE + (size_t)M * NGATE * 2 <= WS_END, "ws map");
constexpr int CW_BAR = 4096;

constexpr int RING_BYTES = 131072;
constexpr int MISC_OFF = RING_BYTES + 320;
constexpr int LDS_BYTES = 147456;

DI unsigned f2bf(float f) { unsigned u = __builtin_bit_cast(unsigned, f); return (u + 0x7fffu + ((u >> 16) & 1u)) >> 16; }
DI unsigned pk2(float lo, float hi) { return f2bf(lo) | (f2bf(hi) << 16); }
typedef float f32x2_t __attribute__((ext_vector_type(2))); typedef __bf16 bf16x2_t __attribute__((ext_vector_type(2)));
DI unsigned cvtpk(float lo, float hi) { f32x2_t v = {lo, hi}; bf16x2_t b = __builtin_convertvector(v, bf16x2_t); return __builtin_bit_cast(unsigned, b); }
DI u32x4 pack8(f32x4 a, f32x4 b) { u32x4 w; w.x = cvtpk(a[0], a[1]); w.y = cvtpk(a[2], a[3]); w.z = cvtpk(b[0], b[1]); w.w = cvtpk(b[2], b[3]); return w; }
DI void unpack8(u32x4 w, f32x4& a, f32x4& b) {
    a = (f32x4){__builtin_bit_cast(float, w.x << 16), __builtin_bit_cast(float, w.x & 0xffff0000u), __builtin_bit_cast(float, w.y << 16), __builtin_bit_cast(float, w.y & 0xffff0000u)};
    b = (f32x4){__builtin_bit_cast(float, w.z << 16), __builtin_bit_cast(float, w.z & 0xffff0000u), __builtin_bit_cast(float, w.w << 16), __builtin_bit_cast(float, w.w & 0xffff0000u)}; }
template <int X> DI float swz_xor(float v) { return __builtin_bit_cast(float, __builtin_amdgcn_ds_swizzle(__builtin_bit_cast(int, v), (X << 10) | 0x1f)); }
DI float sum_halves(float v) { auto rr = __builtin_amdgcn_permlane32_swap(__float_as_uint(v), __float_as_uint(v), false, false); return __uint_as_float(rr[0]) + __uint_as_float(rr[1]); }
DI float wave_sum(float v) { v += swz_xor<1>(v); v += swz_xor<2>(v); v += swz_xor<4>(v); v += swz_xor<8>(v); v += swz_xor<16>(v); return sum_halves(v); }
DI float rs_from(f32x4 s) { return 1.0f / sqrtf(((s[0] + s[1]) + (s[2] + s[3])) * (1.0f / D) + EPS); }
DI float sigm(float v) { return 1.0f / (1.0f + __expf(-v)); }
#define MEMFENCE() asm volatile("" ::: "memory")

using pg8::Unit;
constexpr int HALF = 128;
DI void load_rs8(const float* SS, int row0, float (&rs)[2][4]) {
    f32x4 s[2][4];
#pragma unroll
    for (int ai = 0; ai < 2; ++ai)
#pragma unroll
        for (int m = 0; m < 4; ++m) s[ai][m] = *(const f32x4*)(SS + (size_t)(row0 + ai * HALF + m * 16) * 4);
#pragma unroll
    for (int ai = 0; ai < 2; ++ai)
#pragma unroll
        for (int m = 0; m < 4; ++m) rs[ai][m] = rs_from(s[ai][m]);
}

struct EpiIn {
    static constexpr bool PERM = true, AFTER_DRAIN = false, MIDSCALE = false;
    const float* SS; bf16* QKV; bf16* GATE;
    DI void operator()(const f32x4 (&acc)[2][2][4][2], const Unit& u, int wr, int wc, int fr, int fq) const {
        const int row0 = u.pm * 256 + wr * 64 + fr;
        float rs[2][4]; load_rs8(SS, row0, rs);
        if (u.pn < 9) {
            const float cs = (u.pn < 2 || u.pn == 6 || u.pn == 7) ? C2 : 1.0f;
            const int col0 = u.pn * 256 + wc * 32 + 8 * fq;
#pragma unroll
            for (int ai = 0; ai < 2; ++ai)
#pragma unroll
                for (int m = 0; m < 4; ++m) { const float sc = rs[ai][m] * cs; bf16* rowp = QKV + (size_t)(row0 + ai * HALF + m * 16) * NQKV + col0;
#pragma unroll
                    for (int bj = 0; bj < 2; ++bj) *(u32x4*)(rowp + bj * HALF) = pack8(acc[ai][bj][m][0] * sc, acc[ai][bj][m][1] * sc); }
        } else {
            const int c0 = (u.pn - 9) * 128 + wc * 32 + 8 * fq;
#pragma unroll
            for (int ai = 0; ai < 2; ++ai)
#pragma unroll
                for (int m = 0; m < 4; ++m) { const float r = rs[ai][m]; bf16* rowp = GATE + (size_t)(row0 + ai * HALF + m * 16) * NGATE + c0;
                    f32x4 ra[2], gb[2];
#pragma unroll
                    for (int n = 0; n < 2; ++n)
#pragma unroll
                        for (int j = 0; j < 4; ++j) { const float ea = fminf(__expf(-acc[ai][0][m][n][j] * r), 1e30f), eb = fminf(__expf(-acc[ai][1][m][n][j] * r), 1e30f);
                            const float g = 1.0f / (1.0f + eb); gb[n][j] = g; ra[n][j] = (1.0f + eb) / (1.0f + ea); }
                    *(u32x4*)rowp = pack8(ra[0], ra[1]); *(u32x4*)(rowp + 1024) = pack8(gb[0], gb[1]); }
        }
    }
};
struct EpiUp {
    static constexpr bool PERM = true, AFTER_DRAIN = false, MIDSCALE = true;
    const bf16* GATE; bf16* MRG;
    DI void mid(f32x4 (&acc)[2][2][4][2], const Unit& u, int wr, int wc, int fr, int fq) const {
        const int row0 = u.pm * 256 + wr * 64 + fr, col0 = u.pn * 256 + wc * 32 + 8 * fq;
#pragma unroll
        for (int ai = 0; ai < 2; ++ai)
#pragma unroll
            for (int m = 0; m < 4; ++m) { const bf16* rowp = GATE + (size_t)(row0 + ai * HALF + m * 16) * NGATE + col0;
#pragma unroll
                for (int bj = 0; bj < 2; ++bj) { f32x4 a, b; unpack8(*(const u32x4*)(rowp + bj * HALF), a, b); acc[ai][bj][m][0] *= a; acc[ai][bj][m][1] *= b; }
                MEMFENCE(); }
    }
    DI void operator()(const f32x4 (&acc)[2][2][4][2], const Unit& u, int wr, int wc, int fr, int fq) const {
        const int row0 = u.pm * 256 + wr * 64 + fr, col0 = u.pn * 256 + wc * 32 + 8 * fq;
#pragma unroll
        for (int ai = 0; ai < 2; ++ai)
#pragma unroll
            for (int m = 0; m < 4; ++m) { const size_t r = (size_t)(row0 + ai * HALF + m * 16);
#pragma unroll
                for (int bj = 0; bj < 2; ++bj) { f32x4 a, b; unpack8(*(const u32x4*)(GATE + r * NGATE + 1024 + col0 + bj * HALF), a, b);
                    *(u32x4*)(MRG + r * D + col0 + bj * HALF) = pack8(acc[ai][bj][m][0] * a, acc[ai][bj][m][1] * b); }
                if (m & 1) MEMFENCE(); }
    }
};
struct EpiFf1 {
    static constexpr bool PERM = true, AFTER_DRAIN = false, MIDSCALE = false;
    const float* SS; bf16* U;
    DI void operator()(const f32x4 (&acc)[2][2][4][2], const Unit& u, int wr, int wc, int fr, int fq) const {
        const int row0 = u.pm * 256 + wr * 64 + fr, col0 = u.pn * 256 + wc * 32 + 8 * fq;
        float rs[2][4]; load_rs8(SS, row0, rs);
#pragma unroll
        for (int ai = 0; ai < 2; ++ai)
#pragma unroll
            for (int m = 0; m < 4; ++m) { const float r = rs[ai][m]; bf16* rowp = U + (size_t)(row0 + ai * HALF + m * 16) * FF + col0;
#pragma unroll
                for (int bj = 0; bj < 2; ++bj) { f32x4 v0 = acc[ai][bj][m][0] * r, v1 = acc[ai][bj][m][1] * r;
#pragma unroll
                    for (int j = 0; j < 4; ++j) { const float a = fmaxf(v0[j], 0.f), b = fmaxf(v1[j], 0.f); v0[j] = a * a; v1[j] = b * b; }
                    *(u32x4*)(rowp + bj * HALF) = pack8(v0, v1); } }
    }
};
struct EpiPe {
    static constexpr bool PERM = true, AFTER_DRAIN = false, MIDSCALE = false;
    bf16* PE;
    DI void operator()(const f32x4 (&acc)[2][2][4][2], const Unit& u, int wr, int wc, int fr, int fq) const {
        const int row0 = u.pm * 256 + wr * 64 + fr, col0 = u.pn * 256 + wc * 32 + 8 * fq;
#pragma unroll
        for (int ai = 0; ai < 2; ++ai)
#pragma unroll
            for (int m = 0; m < 4; ++m) { bf16* rowp = PE + (size_t)(row0 + ai * HALF + m * 16) * D + col0;
#pragma unroll
                for (int bj = 0; bj < 2; ++bj) *(u32x4*)(rowp + bj * HALF) = pack8(acc[ai][bj][m][0], acc[ai][bj][m][1]); }
    }
};
template <bool GATED> struct EpiRes {
    static constexpr bool PERM = true, AFTER_DRAIN = true, MIDSCALE = false;
    const float* xin; float* xout; bf16* XB; float* SS; const bf16* PE; const float* SSr;
    DI void fused(f32x4 (&acc)[2][2][4][2], const Unit& u, int wr, int wc, int fr, int fq, LAS unsigned char* lds, int wid, int lane) const {
        const int row0 = u.pm * 256 + wr * 64 + fr, col0 = u.pn * 256 + wc * 32 + 8 * fq;
        LAS float* P = (LAS float*)lds;
        float rs[2][4];
        if (GATED) load_rs8(SSr, row0, rs);
        MEMFENCE();
#pragma unroll
        for (int ai = 0; ai < 2; ++ai)
#pragma unroll
            for (int m = 0; m < 4; ++m) { const size_t r = (size_t)(row0 + ai * HALF + m * 16); float ss = 0.f;
#pragma unroll
                for (int bj = 0; bj < 2; ++bj) { const size_t o = r * D + col0 + bj * HALF;
                    f32x4 x0 = *(const f32x4*)(xin + o), x1 = *(const f32x4*)(xin + o + 4), v0 = acc[ai][bj][m][0], v1 = acc[ai][bj][m][1];
                    if (GATED) { f32x4 p0, p1; unpack8(*(const u32x4*)(PE + o), p0, p1); const float rr = rs[ai][m];
#pragma unroll
                        for (int j = 0; j < 4; ++j) { v0[j] = p0[j] * sigm(v0[j] * rr); v1[j] = p1[j] * sigm(v1[j] * rr); } }
                    x0 += v0; x1 += v1;
                    *(f32x4*)(xout + o) = x0; *(f32x4*)(xout + o + 4) = x1; *(u32x4*)(XB + o) = pack8(x0, x1);
                    ss += ((x0[0] * x0[0] + x0[1] * x0[1]) + (x0[2] * x0[2] + x0[3] * x0[3])) + ((x1[0] * x1[0] + x1[1] * x1[1]) + (x1[2] * x1[2] + x1[3] * x1[3])); }
                ss += swz_xor<16>(ss); ss = sum_halves(ss);
                if (fq == 0) P[(ai * HALF + wr * 64 + m * 16 + fr) * 4 + wc] = ss;
                if (m & 1) MEMFENCE(); }
        __syncthreads();
        if (wid < 4) { const int row = wid * 64 + lane; const f32x4 p = *(const LAS f32x4*)(P + row * 4);
            SS[(size_t)(u.pm * 256 + row) * 4 + u.pn] = (p[0] + p[1]) + (p[2] + p[3]); }
        __syncthreads();
    }
};


namespace att {
typedef short s16x4 __attribute__((ext_vector_type(4)));
typedef float f32x16 __attribute__((ext_vector_type(16)));
typedef LAS const char* lds_cptr;
#define SBAR() __builtin_amdgcn_sched_barrier(0)
#define MFMA32(a, b, c) __builtin_amdgcn_mfma_f32_32x32x16_bf16((a), (b), (c), 0, 0, 0)
DI int crow(int r, int hi) { return (r & 3) + 8 * (r >> 2) + 4 * hi; }
DI void qkt(f32x16& p0, f32x16& p1, lds_cptr Kslot, const bf16x8* qr, int r32, int hi) {
    const lds_cptr kb = Kslot + hi * 1024 + r32 * 16;
    f32x16 z0 = {}, z1 = {};
#pragma unroll
    for (int d0 = 0; d0 < 4; ++d0) {
        const bf16x8 b0 = *(const LAS bf16x8*)(kb + d0 * 2048), b1 = *(const LAS bf16x8*)(kb + d0 * 2048 + 512);
        z0 = MFMA32(b0, qr[d0], z0); z1 = MFMA32(b1, qr[d0], z1); }
    p0 = z0; p1 = z1;
}
DI void pv(f32x16* o, int vb, bf16x8 pa0, bf16x8 pa1, bf16x8 pa2, bf16x8 pa3) {
#pragma unroll
    for (int d0 = 0; d0 < 2; ++d0) { s16x4 lo[4], hi[4];
#pragma unroll
        for (int ks = 0; ks < 4; ++ks) {
            asm volatile("ds_read_b64_tr_b16 %0,%1 offset:%c2" : "=&v"(lo[ks]) : "v"(vb), "i"(d0 * 4096 + ks * 1024) : "memory");
            asm volatile("ds_read_b64_tr_b16 %0,%1 offset:%c2" : "=&v"(hi[ks]) : "v"(vb), "i"(d0 * 4096 + ks * 1024 + 512) : "memory"); }
        asm volatile("s_waitcnt lgkmcnt(0)" ::: "memory"); SBAR();
#define PK(k) (bf16x8){lo[k][0], lo[k][1], lo[k][2], lo[k][3], hi[k][0], hi[k][1], hi[k][2], hi[k][3]}
        o[d0] = MFMA32(pa0, PK(0), o[d0]); o[d0] = MFMA32(pa1, PK(1), o[d0]); o[d0] = MFMA32(pa2, PK(2), o[d0]); o[d0] = MFMA32(pa3, PK(3), o[d0]);
#undef PK
    }
}
DI int vlane_ofs(int lane, int hi) { return ((lane >> 4) & 1) * 32 + (lane & 3) * 8 + (4 * hi + ((lane & 15) >> 2)) * 64; }
DI float other_half(float v, int hi) { auto rr = __builtin_amdgcn_permlane32_swap(__float_as_uint(v), __float_as_uint(v), false, false); return __uint_as_float(hi ? rr[0] : rr[1]); }
DI void pack_p(const f32x16& p0, const f32x16& p1, u32x4& w0, u32x4& w1, u32x4& w2, u32x4& w3) {
    w0 = (u32x4){cvtpk(p0[0], p0[1]), cvtpk(p0[2], p0[3]), cvtpk(p0[4], p0[5]), cvtpk(p0[6], p0[7])};
    w1 = (u32x4){cvtpk(p0[8], p0[9]), cvtpk(p0[10], p0[11]), cvtpk(p0[12], p0[13]), cvtpk(p0[14], p0[15])};
    w2 = (u32x4){cvtpk(p1[0], p1[1]), cvtpk(p1[2], p1[3]), cvtpk(p1[4], p1[5]), cvtpk(p1[6], p1[7])};
    w3 = (u32x4){cvtpk(p1[8], p1[9]), cvtpk(p1[10], p1[11]), cvtpk(p1[12], p1[13]), cvtpk(p1[14], p1[15])};
}
DI void store_o(const f32x16* o, const float* scale, LAS bf16* stg, bf16* Ow, int pitch, int lane, int r32, int hi) {
#pragma unroll
    for (int r = 0; r < 16; ++r) { const int orow = crow(r, hi); const float sc = scale ? scale[r] : 1.0f;
#pragma unroll
        for (int d0 = 0; d0 < 2; ++d0) stg[orow * 64 + d0 * 32 + r32] = (bf16)f2bf(o[d0][r] * sc); }
    asm volatile("s_waitcnt lgkmcnt(0)" ::: "memory");
#pragma unroll
    for (int i = 0; i < 4; ++i) { const int row = i * 8 + (lane >> 3), ch = lane & 7; const u32x4 v = *(const LAS u32x4*)(stg + row * 64 + ch * 8); *(u32x4*)(Ow + (long)row * pitch + ch * 8) = v; }
}

DI void sb_math(f32x16& p0, f32x16& p1, float& carry, int kb, int qabs, bool need_mask, int hi) {
    f32x16 lb0, lb1;
#pragma unroll
    for (int r = 0; r < 16; ++r) {
        { const float y = p0[r], L = __builtin_amdgcn_logf(1.0f + __builtin_amdgcn_exp2f(-__builtin_fabsf(y))); lb0[r] = __builtin_fminf(y, 0.f) - L; p0[r] = __builtin_fminf(-y, 0.f) - L; }
        { const float y = p1[r], L = __builtin_amdgcn_logf(1.0f + __builtin_amdgcn_exp2f(-__builtin_fabsf(y))); lb1[r] = __builtin_fminf(y, 0.f) - L; p1[r] = __builtin_fminf(-y, 0.f) - L; } }
    if (need_mask) {
#pragma unroll
        for (int r = 0; r < 16; ++r) { const int key = kb + (r & 3) + 8 * (r >> 2);
            if (key >= qabs) { p0[r] = 0.f; lb0[r] = -INFINITY; }
            if (key + 32 >= qabs) { p1[r] = 0.f; lb1[r] = -INFINITY; } } }
    float gs0[4], gs1[4], og0[4], og1[4];
#pragma unroll
    for (int g = 0; g < 4; ++g) { gs0[g] = (p0[4 * g] + p0[4 * g + 1]) + (p0[4 * g + 2] + p0[4 * g + 3]); gs1[g] = (p1[4 * g] + p1[4 * g + 1]) + (p1[4 * g + 2] + p1[4 * g + 3]); }
#pragma unroll
    for (int g = 0; g < 4; ++g) { og0[g] = other_half(gs0[g], hi); og1[g] = other_half(gs1[g], hi); }
    const float oth = hi ? 0.f : 1.f;
    float T = carry;
#pragma unroll
    for (int g = 3; g >= 0; --g) { float S = T + oth * og1[g]; T += gs1[g] + og1[g];
        const float a3 = __builtin_amdgcn_exp2f(lb1[4 * g + 3] + S); S += p1[4 * g + 3];
        const float a2 = __builtin_amdgcn_exp2f(lb1[4 * g + 2] + S); S += p1[4 * g + 2];
        const float a1 = __builtin_amdgcn_exp2f(lb1[4 * g + 1] + S); S += p1[4 * g + 1];
        const float a0 = __builtin_amdgcn_exp2f(lb1[4 * g] + S);
        p1[4 * g] = a0; p1[4 * g + 1] = a1; p1[4 * g + 2] = a2; p1[4 * g + 3] = a3; }
#pragma unroll
    for (int g = 3; g >= 0; --g) { float S = T + oth * og0[g]; T += gs0[g] + og0[g];
        const float a3 = __builtin_amdgcn_exp2f(lb0[4 * g + 3] + S); S += p0[4 * g + 3];
        const float a2 = __builtin_amdgcn_exp2f(lb0[4 * g + 2] + S); S += p0[4 * g + 2];
        const float a1 = __builtin_amdgcn_exp2f(lb0[4 * g + 1] + S); S += p0[4 * g + 1];
        const float a0 = __builtin_amdgcn_exp2f(lb0[4 * g] + S);
        p0[4 * g] = a0; p0[4 * g + 1] = a1; p0[4 * g + 2] = a2; p0[4 * g + 3] = a3; }
    carry = T;
}
constexpr int SB_K = 0, SB_V = 16384, SB_FLAG = 32768, SB_STG = 33792, SB_LDS = SB_STG + NWAVES * 4096;
constexpr float SB_DONE = -152.0f;
template <bool EARLY> DI void sb_unit(int b, int h, int qb, const bf16* QKV, bf16* ATT, LAS char* shm, const int tid_in) {
    int tid_ = tid_in; asm volatile("" : "+v"(tid_));
    const int tid = tid_, lane = tid & 63, r32 = lane & 31, hi = lane >> 5; const int wid = __builtin_amdgcn_readfirstlane(tid >> 6);
    const long rowbase = (long)b * SEQ; const int q0 = qb * 256;
    const bf16* Qw = QKV + (rowbase + q0 + wid * 32) * NQKV + h * 64;
    const bf16* ksrc = QKV + rowbase * NQKV + 512 + h * 64 + (long)lane * NQKV + wid * 8;
    const bf16* vsrc = QKV + rowbase * NQKV + 1024 + h * 64 + (long)(16 * (wid & 3) + (lane >> 2)) * NQKV + (wid >> 2) * 32 + (lane & 3) * 8;
    const int wofs = wid * 1024 + lane * 16;
    LAS unsigned* flags = (LAS unsigned*)(shm + SB_FLAG);
    bf16x8 qr[4];
#pragma unroll
    for (int d0 = 0; d0 < 4; ++d0) qr[d0] = *(const bf16x8*)(Qw + (long)r32 * NQKV + d0 * 16 + hi * 8);
    f32x16 o[2]; o[0] = f32x16{}; o[1] = f32x16{};
    float carry = 0.f;
    const int T0 = (q0 >> 6) + 3, qmin = q0 + wid * 32, qmax = qmin + 31, qabs = qmin + r32;
    const int vofs = (int)(uintptr_t)(shm + SB_V) + vlane_ofs(lane, hi);
    u32x4 kreg = *(const u32x4*)(ksrc + (long)T0 * 64 * NQKV), vreg = *(const u32x4*)(vsrc + (long)T0 * 64 * NQKV);
    *(LAS u32x4*)(shm + SB_K + wofs) = kreg; *(LAS u32x4*)(shm + SB_V + wofs) = vreg;
    __syncthreads();
    bool done = false;
    for (int jt = T0, it = 0; jt >= 0; --jt, ++it) {
        const int slot = (it & 1) * 8192;
        if (jt > 0) { kreg = *(const u32x4*)(ksrc + (long)(jt - 1) * 64 * NQKV); vreg = *(const u32x4*)(vsrc + (long)(jt - 1) * 64 * NQKV); }
        if (!done && 64 * jt < qmax) {
            f32x16 p0, p1; qkt(p0, p1, (lds_cptr)(shm + SB_K + slot), qr, r32, hi);
            sb_math(p0, p1, carry, 64 * jt + 4 * hi, qabs, 64 * jt + 63 >= qmin, hi);
            u32x4 w0, w1, w2, w3; pack_p(p0, p1, w0, w1, w2, w3);
            pv(o, vofs + slot, __builtin_bit_cast(bf16x8, w0), __builtin_bit_cast(bf16x8, w1), __builtin_bit_cast(bf16x8, w2), __builtin_bit_cast(bf16x8, w3));
            if (EARLY) done = __all(carry < SB_DONE) != 0;
        }
        if (jt > 0) { *(LAS u32x4*)(shm + SB_K + (slot ^ 8192) + wofs) = kreg; *(LAS u32x4*)(shm + SB_V + (slot ^ 8192) + wofs) = vreg; }
        if (EARLY) { if (lane == 0) flags[(it & 1) * 8 + wid] = done ? 1u : 0u; }
        __syncthreads();
        if (EARLY) { const u32x4 f0 = *(const LAS u32x4*)(flags + (it & 1) * 8), f1 = *(const LAS u32x4*)(flags + (it & 1) * 8 + 4);
            if ((f0.x & f0.y & f0.z & f0.w & f1.x & f1.y & f1.z & f1.w) != 0u) break; }
    }
    store_o(o, nullptr, (LAS bf16*)(shm + SB_STG + wid * 4096), ATT + (rowbase + q0 + wid * 32) * D + h * 64, D, lane, r32, hi);
    __syncthreads();
}

constexpr int SW_K = 0, SW_V = 49152, SW_BT = 98304, SW_WS = 98816, SW_LDS = SW_WS + NWAVES * 256;
DI void swa_unit(int b, int h, int qb, int layer, const bf16* QKV, const float* BT, bf16* ATT, LAS char* shm, const int tid_in) {
    int tid_ = tid_in; asm volatile("" : "+v"(tid_));
    const int tid = tid_, lane = tid & 63, r32 = lane & 31, hi = lane >> 5; const int wid = __builtin_amdgcn_readfirstlane(tid >> 6);
    const long rowbase = (long)b * SEQ; const int q0 = qb * 256, kvh = h >> 2;
    const bf16* Qw = QKV + (rowbase + q0 + wid * 32) * NQKV + 1536 + h * 64;
    const bf16* ksrc = QKV + rowbase * NQKV + 2048 + kvh * 64 + (long)lane * NQKV + wid * 8;
    const bf16* vsrc = QKV + rowbase * NQKV + 2176 + kvh * 64 + (long)(16 * (wid & 3) + (lane >> 2)) * NQKV + (wid >> 2) * 32 + (lane & 3) * 8;
    const int wofs = wid * 1024 + lane * 16, jt0 = (q0 >> 6) - 2;
#pragma unroll
    for (int i = 0; i < 6; ++i) { const int jt = jt0 + i;
        if (jt >= 0) { const u32x4 k = *(const u32x4*)(ksrc + (long)jt * 64 * NQKV), v = *(const u32x4*)(vsrc + (long)jt * 64 * NQKV);
            *(LAS u32x4*)(shm + SW_K + i * 8192 + wofs) = k; *(LAS u32x4*)(shm + SW_V + i * 8192 + wofs) = v; } }
    LAS float* btl = (LAS float*)(shm + SW_BT);
    if (tid < 128) btl[tid] = BT[h * 128 + tid];
    bf16x8 qr[4];
#pragma unroll
    for (int d0 = 0; d0 < 4; ++d0) qr[d0] = *(const bf16x8*)(Qw + (long)r32 * NQKV + d0 * 16 + hi * 8);
    const float sink = BT[1024 + layer * 8 + h];
    __syncthreads();
    const int qabs = q0 + wid * 32 + r32, i_lo = wid >> 1;
    const int vofs = (int)(uintptr_t)(shm + SW_V) + vlane_ofs(lane, hi);
    float m = -INFINITY;
#pragma unroll 1
    for (int ii = 0; ii < 3; ++ii) { const int i = i_lo + ii, jt = jt0 + i; if (jt < 0) continue;
        f32x16 p0, p1; qkt(p0, p1, (lds_cptr)(shm + SW_K + i * 8192), qr, r32, hi);
        const int db = qabs - (64 * jt + 4 * hi);
#pragma unroll
        for (int r = 0; r < 16; ++r) { const int d0_ = db - ((r & 3) + 8 * (r >> 2)), d1_ = d0_ - 32;
            const float s0 = p0[r] + btl[d0_ & 127], s1 = p1[r] + btl[d1_ & 127];
            if ((unsigned)d0_ < 128u) m = __builtin_fmaxf(m, s0);
            if ((unsigned)d1_ < 128u) m = __builtin_fmaxf(m, s1); } }
    m = __builtin_fmaxf(m, other_half(m, hi)); m = __builtin_fmaxf(m, sink);
    f32x16 o[2]; o[0] = f32x16{}; o[1] = f32x16{};
    float l = 0.f;
#pragma unroll 1
    for (int ii = 0; ii < 3; ++ii) { const int i = i_lo + ii, jt = jt0 + i; if (jt < 0) continue;
        f32x16 p0, p1; qkt(p0, p1, (lds_cptr)(shm + SW_K + i * 8192), qr, r32, hi);
        const int db = qabs - (64 * jt + 4 * hi);
#pragma unroll
        for (int r = 0; r < 16; ++r) { const int d0_ = db - ((r & 3) + 8 * (r >> 2)), d1_ = d0_ - 32;
            const float e0 = __builtin_amdgcn_exp2f(p0[r] + btl[d0_ & 127] - m), e1 = __builtin_amdgcn_exp2f(p1[r] + btl[d1_ & 127] - m);
            p0[r] = (unsigned)d0_ < 128u ? e0 : 0.f; p1[r] = (unsigned)d1_ < 128u ? e1 : 0.f; l += p0[r] + p1[r]; }
        u32x4 w0, w1, w2, w3; pack_p(p0, p1, w0, w1, w2, w3);
        pv(o, vofs + i * 8192, __builtin_bit_cast(bf16x8, w0), __builtin_bit_cast(bf16x8, w1), __builtin_bit_cast(bf16x8, w2), __builtin_bit_cast(bf16x8, w3)); }
    l += other_half(l, hi); l += __builtin_amdgcn_exp2f(sink - m);
    LAS float* wsf = (LAS float*)(shm + SW_WS) + wid * 64;
    if (hi == 0) wsf[r32] = 1.0f / l;
    asm volatile("s_waitcnt lgkmcnt(0)" ::: "memory");
    float rli[16];
#pragma unroll
    for (int r = 0; r < 16; ++r) rli[r] = wsf[crow(r, hi)];
    __syncthreads();
    store_o(o, rli, (LAS bf16*)(shm + wid * 4096), ATT + (rowbase + q0 + wid * 32) * D + 512 + h * 64, D, lane, r32, hi);
    __syncthreads();
}
#undef SBAR
#undef MFMA32
}

#define XB_TMO      128
#define XB_XCNT(j)  (256  + 64 * (j))
#define XB_XSUB(j)  (1280 + 64 * (j))
#define XB_XGEN(j)  (2304 + 64 * (j))
#define XB_TOP      3328
#define XB_TOPGEN   3392
#define XCD_BAR_WORDS 3456
#define XB_SPIN_CAP (1u << 18)

__device__ __forceinline__ unsigned xb_ld(unsigned* p)              { return __hip_atomic_load(p, __ATOMIC_RELAXED, __HIP_MEMORY_SCOPE_AGENT); }
__device__ __forceinline__ unsigned xb_add(unsigned* p, unsigned v) { return __hip_atomic_fetch_add(p, v, __ATOMIC_RELAXED, __HIP_MEMORY_SCOPE_AGENT); }
__device__ __forceinline__ unsigned xb_xcc_id() { return (unsigned)__builtin_amdgcn_s_getreg((3 << 11) | 20) & 0xFu; }
#define XB_SPIN(cond, bar) do { unsigned _sp = 0; while (cond) { __builtin_amdgcn_s_sleep(1); \
    if ((++_sp & 255u) == 0u) { if (xb_ld(&(bar)[XB_TMO])) break; if (_sp > XB_SPIN_CAP) { atomicAdd(&(bar)[XB_TMO], 1u); break; } } } } while (0)

struct XcdBarrier {
    unsigned* bar; unsigned x;
    volatile LAS unsigned* st;
};

__device__ __forceinline__ XcdBarrier xcd_barrier_post(unsigned* bar, volatile LAS unsigned* st) {
    XcdBarrier b; b.bar = bar; b.x = xb_xcc_id(); b.st = st;
    if (threadIdx.x == 0) (void)xb_add(&bar[XB_XCNT(b.x)], 1u);
    return b;
}
__device__ __forceinline__ void xcd_barrier_complete(unsigned* bar, unsigned x, unsigned& nloc, unsigned& nx) {
    const unsigned G = gridDim.x * gridDim.y * gridDim.z;
    unsigned sum, cnt, mine, sp = 0u;
    for (;;) {
        sum = 0u; cnt = 0u; mine = 0u;
#pragma unroll
        for (unsigned j = 0; j < 16; ++j) { const unsigned c = xb_ld(&bar[XB_XCNT(j)]); sum += c; cnt += (c > 0u) ? 1u : 0u; mine = (j == x) ? c : mine; }
        if (sum == G) break;
        __builtin_amdgcn_s_sleep(1);
        if ((++sp & 255u) == 0u) { if (xb_ld(&bar[XB_TMO])) break; if (sp > XB_SPIN_CAP) { atomicAdd(&bar[XB_TMO], 1u); break; } }
    }
    nloc = mine > 0u ? mine : 1u; nx = cnt > 0u ? cnt : 1u;
}

__device__ __forceinline__ void xcd_barrier(const XcdBarrier& b, const bool is_t0  ) {
    asm volatile("s_waitcnt vmcnt(0)" ::: "memory");
    __syncthreads();
    if (is_t0) {
        unsigned* bar = b.bar;
        __builtin_amdgcn_s_waitcnt(0);
        unsigned nloc = b.st[0], nx = b.st[1];
        if (nloc == 0u) { xcd_barrier_complete(bar, b.x, nloc, nx); b.st[0] = nloc; b.st[1] = nx; }
        const unsigned old = xb_add(&bar[XB_XSUB(b.x)], 1u);
        const unsigned gen = old / nloc;
        if (old + 1u == (gen + 1u) * nloc) {
            __builtin_amdgcn_fence(__ATOMIC_RELEASE, "agent");
            asm volatile("s_waitcnt vmcnt(0)" ::: "memory");
            const unsigned og = xb_add(&bar[XB_TOP], 1u);
            const unsigned tg = og / nx;
            if (og + 1u == (tg + 1u) * nx) xb_add(&bar[XB_TOPGEN], 1u);
            else XB_SPIN(xb_ld(&bar[XB_TOPGEN]) == tg, bar);
            __builtin_amdgcn_fence(__ATOMIC_ACQUIRE, "agent");
            xb_add(&bar[XB_XGEN(b.x)], 1u);
            asm volatile("s_waitcnt vmcnt(0)" ::: "memory");
        } else {
            XB_SPIN(xb_ld(&bar[XB_XGEN(b.x)]) == gen, bar);
            __builtin_amdgcn_fence(__ATOMIC_ACQUIRE, "agent");
            asm volatile("s_waitcnt vmcnt(0)" ::: "memory");
        }
    }
    __syncthreads();
}


DI void conv_w(const float* W, const float* g, bf16* WT, int K, int N, int ldk, int koff, bool perm_gate, LAS float* scr, int gw, int NGW, int lane) {
    const int nblk = N / 32, nitems = (K / 64) * nblk;
    for (int item = gw; item < nitems; item += NGW) {
        const int kb = item / nblk, nb = item % nblk, k0 = 64 * kb, n0 = 32 * nb;
        int nd = n0;
        if (perm_gate && n0 >= NQKV) { const int c = n0 - NQKV; nd = c < 1024 ? NQKV + 256 * (c >> 7) + (c & 127) : NQKV + 256 * ((c - 1024) >> 7) + 128 + ((c - 1024) & 127); }
#pragma unroll 8
        for (int i = 0; i < 32; ++i) { const int kk = 2 * i + (lane >> 5); const float gs = g ? g[k0 + kk] : 1.0f; scr[kk * 33 + (lane & 31)] = W[(size_t)(k0 + kk) * N + n0 + (lane & 31)] * gs; }
        asm volatile("s_waitcnt lgkmcnt(0)" ::: "memory");
        const int c = lane & 7;
#pragma unroll
        for (int j = 0; j < 4; ++j) { const int n = (lane >> 3) + 8 * j; const LAS float* s = scr + (8 * c) * 33 + n;
            u32x4 o; o.x = pk2(s[0 * 33], s[1 * 33]); o.y = pk2(s[2 * 33], s[3 * 33]); o.z = pk2(s[4 * 33], s[5 * 33]); o.w = pk2(s[6 * 33], s[7 * 33]);
            *(u32x4*)(WT + (size_t)(nd + n) * ldk + koff + k0 + 8 * c) = o; }
        asm volatile("s_waitcnt lgkmcnt(0)" ::: "memory");
    }
}
DI void rownorm_rows(const float* x, bf16* XB, float* SS, int gw, int NGW, int lane) {
    for (int row = gw; row < M; row += NGW) {
        const f32x4* xr = (const f32x4*)(x + (size_t)row * D) + lane; u32x2* o = (u32x2*)(XB + (size_t)row * D) + lane;
        float s = 0.f;
#pragma unroll
        for (int j = 0; j < 4; ++j) { const f32x4 v = xr[64 * j]; s += (v[0] * v[0] + v[1] * v[1]) + (v[2] * v[2] + v[3] * v[3]); u32x2 w; w.x = cvtpk(v[0], v[1]); w.y = cvtpk(v[2], v[3]); o[64 * j] = w; }
        s = wave_sum(s);
        if (lane == 0) *(f32x4*)(SS + (size_t)row * 4) = (f32x4){s, 0.f, 0.f, 0.f};
    }
}
DI void final_rows(float* x, const float* SS, const float* gf, int gw, int NGW, int lane) {
    for (int row = gw; row < M; row += NGW) {
        f32x4* xr = (f32x4*)(x + (size_t)row * D) + lane; const f32x4* g4 = (const f32x4*)gf + lane;
        const float r = rs_from(*(const f32x4*)(SS + (size_t)row * 4));
#pragma unroll
        for (int j = 0; j < 4; ++j) xr[64 * j] = (xr[64 * j] * r) * g4[64 * j];
    }
}
DI int t5_bucket(int d) {
    if (d < 16) return d;
    const int large = 16 + (int)(logf((float)d / 16.0f) / 2.0794415416798357f * 16.0f);
    return large < 31 ? large : 31;
}

#ifndef MK_N_LAUNCHES
#define MK_N_LAUNCHES 1
#endif
constexpr int NPH = 16;
struct Args { const float* in[16]; float* out; unsigned char* ws; int ph_lo, ph_hi; };
static_assert(sizeof(Args) == 16 * 8 + 8 + 8 + 8, "Args has no padding");

typedef const __attribute__((address_space(4))) Args* KArgs;
DI KArgs kargs() { KArgs p = (KArgs)__builtin_amdgcn_kernarg_segment_ptr(); asm volatile("" : "+s"(p)); return p; }
struct Ctx { int tid, lane, wave, G, bx, vcu, gw, NGW; };
DI Ctx ctx(int wv) { Ctx c; int z = 0; asm volatile("" : "+v"(z)); const int ln = __builtin_amdgcn_mbcnt_hi(~0u, __builtin_amdgcn_mbcnt_lo(~0u, z)); int t = wv * 64 + ln; asm volatile("" : "+v"(t));
    int b = blockIdx.x; asm volatile("" : "+s"(b)); c.tid = t; c.lane = ln; c.wave = wv;
    c.G = gridDim.x; c.bx = b; c.vcu = (c.G % 8 == 0) ? (b % 8) * (c.G / 8) + b / 8 : b; c.gw = c.vcu * NWAVES + c.wave; c.NGW = c.G * NWAVES; return c; }
#define WSP(T, off) ((T*)(A->ws + (off)))
__global__ void __launch_bounds__(NWAVES * 64, 2) mk_fwd(Args args_unused) {
    extern __shared__ __attribute__((aligned(16))) unsigned char lds_raw[];
    LAS unsigned char* lds = (LAS unsigned char*)lds_raw;
    volatile LAS unsigned* MISC = (volatile LAS unsigned*)(lds + MISC_OFF);
    const int wv = __builtin_amdgcn_readfirstlane(threadIdx.x >> 6);
    for (int u = threadIdx.x; u < (LDS_BYTES - RING_BYTES) / 4; u += NWAVES * 64) ((LAS unsigned*)(lds + RING_BYTES))[u] = 0u;
    __syncthreads();
    int lo, hi;
    XcdBarrier bar;
    { KArgs A = kargs(); lo = A->ph_lo; hi = A->ph_hi; bar.bar = WSP(unsigned, WS_CTL) + CW_BAR; bar.x = 0; bar.st = nullptr;
      if (MK_N_LAUNCHES == 1) bar = xcd_barrier_post(WSP(unsigned, WS_CTL) + CW_BAR, MISC + 8); }
#define IN(k) (lo <= (k) && (k) < hi)
#define SEAM(k) do { if (IN(k) && IN((k) + 1)) { XcdBarrier b_ = bar; asm volatile("" : "+s"(b_.bar)); const Ctx cb_ = ctx(wv); xcd_barrier(b_, cb_.tid == 0); } } while (0)
#define CONV(W, g, WT, K, N, ldk, koff, perm) conv_w((W), (g), (WT), (K), (N), (ldk), (koff), (perm), (LAS float*)(lds + c.wave * 16384), c.gw, c.NGW, c.lane)

    if (IN(0)) {
        KArgs A = kargs(); const Ctx c = ctx(wv);
        float* BT = WSP(float, WS_BT);
        if (c.bx == 0) { const float* rel_bias = A->in[15]; const float* sinks = A->in[14];
            for (int i = c.tid; i < 8 * 128; i += NWAVES * 64) { const int h = i >> 7, d = i & 127; BT[i] = rel_bias[t5_bucket(d) * 8 + h] * LOG2E; }
            if (c.tid < 16) BT[1024 + c.tid] = sinks[c.tid] * LOG2E; }
        CONV(A->in[2], A->in[10], WSP(bf16, WS_WIN), D, NIN, D, 0, true);
        CONV(A->in[3], nullptr, WSP(bf16, WS_WUP), 512, D, D, 0, false); CONV(A->in[4], nullptr, WSP(bf16, WS_WUP), 512, D, D, 512, false);
        CONV(A->in[5], nullptr, WSP(bf16, WS_WO), D, D, D, 0, false);
        CONV(A->in[6], A->in[11], WSP(bf16, WS_WFF1), D, FF, D, 0, false); CONV(A->in[7], nullptr, WSP(bf16, WS_WFF2), FF, D, FF, 0, false);
        CONV(A->in[8], nullptr, WSP(bf16, WS_WPE), PLE, D, PLE, 0, false); CONV(A->in[9], A->in[12], WSP(bf16, WS_WPG), D, D, D, 0, false);
        { const float* p_in = A->in[1]; bf16* PB = WSP(bf16, WS_PB);
          for (size_t i = (size_t)c.vcu * (NWAVES * 64) + c.tid; i < (size_t)DEPTH * M * PLE / 4; i += (size_t)c.G * NWAVES * 64) {
            const f32x4 v = ((const f32x4*)p_in)[i]; u32x2 o; o.x = cvtpk(v[0], v[1]); o.y = cvtpk(v[2], v[3]); ((u32x2*)PB)[i] = o; } }
        rownorm_rows(A->in[0], WSP(bf16, WS_XB), WSP(float, WS_SS), c.gw, c.NGW, c.lane);
        __syncthreads();
    }
    SEAM(0);
#pragma unroll 1
    for (int l = 0; l < DEPTH; ++l) {
        const int pb = 1 + 7 * l;
#define SSA WSP(float, WS_SS + (l == 0 ? 0 : (size_t)M * 16))
#define SSB WSP(float, WS_SS + (l == 0 ? (size_t)M * 16 : 0))
        if (IN(pb)) {
            KArgs A = kargs(); const Ctx c = ctx(wv);
            if (l == 1) { CONV(A->in[9] + (size_t)D * D, A->in[12] + D, WSP(bf16, WS_WPG), D, D, D, 0, false); __syncthreads(); }
            pg8::Gemm g{l == 0 ? WSP(bf16, WS_XB) : WSP(bf16, WS_PE), WSP(bf16, WS_WIN), M, NIN, D}; pg8::StaticOrder S; S.init(M, NIN, c.G, c.bx);
            EpiIn E{SSA, WSP(bf16, WS_QKV), WSP(bf16, WS_GATE)};
            pg8::gemm_phase<EpiIn, pg8::StaticOrder, true, true>(lds, g, S, E, c.tid);
        }
        SEAM(pb);
        if (IN(pb + 1)) {
            KArgs A = kargs(); const Ctx c = ctx(wv);
            if (l == 0) { CONV(A->in[2] + (size_t)D * NIN, A->in[10] + D, WSP(bf16, WS_WIN), D, NIN, D, 0, true); __syncthreads(); }
            const int bh = c.vcu >> 3, s = c.vcu & 7;
            if (c.G == 256) {
                att::sb_unit<true>(bh >> 3, bh & 7, s, WSP(bf16, WS_QKV), WSP(bf16, WS_ATT), (LAS char*)lds, c.tid);
                att::sb_unit<true>(bh >> 3, bh & 7, 15 - s, WSP(bf16, WS_QKV), WSP(bf16, WS_ATT), (LAS char*)lds, c.tid);
                att::swa_unit(bh >> 3, bh & 7, s, l, WSP(bf16, WS_QKV), WSP(float, WS_BT), WSP(bf16, WS_ATT), (LAS char*)lds, c.tid);
                att::swa_unit(bh >> 3, bh & 7, 15 - s, l, WSP(bf16, WS_QKV), WSP(float, WS_BT), WSP(bf16, WS_ATT), (LAS char*)lds, c.tid);
            }
        }
        SEAM(pb + 1);
        if (IN(pb + 2)) {
            KArgs A = kargs(); const Ctx c = ctx(wv);
            pg8::Gemm g{WSP(bf16, WS_ATT), WSP(bf16, WS_WUP), M, D, D}; pg8::StaticOrder S; S.init(M, D, c.G, c.bx);
            EpiUp E{WSP(bf16, WS_GATE), WSP(bf16, WS_MRG)};
            pg8::gemm_phase<EpiUp, pg8::StaticOrder, true, true>(lds, g, S, E, c.tid);
        }
        SEAM(pb + 2);
        if (IN(pb + 3)) {
            KArgs A = kargs(); const Ctx c = ctx(wv);
            if (l == 0) { CONV(A->in[3] + (size_t)512 * D, nullptr, WSP(bf16, WS_WUP), 512, D, D, 0, false); CONV(A->in[4] + (size_t)512 * D, nullptr, WSP(bf16, WS_WUP), 512, D, D, 512, false); __syncthreads(); }
            if (c.G == 256) {
                pg8::Gemm g{WSP(bf16, WS_MRG), WSP(bf16, WS_WO), M, D, D}; pg8::StaticOrder S; S.init(M, D, c.G, c.bx);
                EpiRes<false> E{l == 0 ? A->in[0] : (const float*)A->out, A->out, WSP(bf16, WS_XB), SSB, nullptr, nullptr};
                pg8::gemm_phase<EpiRes<false>, pg8::StaticOrder, false, true>(lds, g, S, E, c.tid);
            }
        }
        SEAM(pb + 3);
        if (IN(pb + 4)) {
            KArgs A = kargs(); const Ctx c = ctx(wv);
            if (l == 0) { CONV(A->in[5] + (size_t)D * D, nullptr, WSP(bf16, WS_WO), D, D, D, 0, false); __syncthreads(); }
            { pg8::Gemm g{WSP(bf16, WS_XB), WSP(bf16, WS_WFF1), M, FF, D}; pg8::StaticOrder S; S.init(M, FF, c.G, c.bx);
              EpiFf1 E{SSB, WSP(bf16, WS_U)};
              pg8::gemm_phase<EpiFf1, pg8::StaticOrder, true, true>(lds, g, S, E, c.tid); }
        }
        if (IN(pb + 4)) {
            KArgs A = kargs(); const Ctx c = ctx(wv);
            { pg8::Gemm g{WSP(bf16, WS_PB) + (size_t)l * M * PLE, WSP(bf16, WS_WPE), M, D, PLE}; pg8::StaticOrder S; S.init(M, D, c.G, c.bx);
              EpiPe E{WSP(bf16, WS_PE)};
              pg8::gemm_phase<EpiPe, pg8::StaticOrder, true, true>(lds, g, S, E, c.tid); }
        }
        SEAM(pb + 4);
        if (IN(pb + 5)) {
            KArgs A = kargs(); const Ctx c = ctx(wv);
            if (l == 0) { CONV(A->in[6] + (size_t)D * FF, A->in[11] + D, WSP(bf16, WS_WFF1), D, FF, D, 0, false); CONV(A->in[8] + (size_t)PLE * D, nullptr, WSP(bf16, WS_WPE), PLE, D, PLE, 0, false); __syncthreads(); }
            if (c.G == 256) {
                pg8::Gemm g{WSP(bf16, WS_U), WSP(bf16, WS_WFF2), M, D, FF}; pg8::StaticOrder S; S.init(M, D, c.G, c.bx);
                EpiRes<false> E{A->out, A->out, WSP(bf16, WS_XB), SSA, nullptr, nullptr};
                pg8::gemm_phase<EpiRes<false>, pg8::StaticOrder, false, true>(lds, g, S, E, c.tid);
            }
        }
        SEAM(pb + 5);
        if (IN(pb + 6)) {
            KArgs A = kargs(); const Ctx c = ctx(wv);
            if (l == 0) { CONV(A->in[7] + (size_t)FF * D, nullptr, WSP(bf16, WS_WFF2), FF, D, FF, 0, false); __syncthreads(); }
            if (c.G == 256) {
                pg8::Gemm g{WSP(bf16, WS_XB), WSP(bf16, WS_WPG), M, D, D}; pg8::StaticOrder S; S.init(M, D, c.G, c.bx);
                EpiRes<true> E{A->out, A->out, WSP(bf16, WS_PE), SSB, WSP(bf16, WS_PE), SSA};
                pg8::gemm_phase<EpiRes<true>, pg8::StaticOrder, false, true>(lds, g, S, E, c.tid);
            }
        }
        SEAM(pb + 6);
    }
    if (IN(NPH - 1)) { KArgs A = kargs(); const Ctx c = ctx(wv); final_rows(A->out, WSP(float, WS_SS), A->in[13], c.gw, c.NGW, c.lane); }
#undef IN
#undef SEAM
#undef CONV
}

extern "C" void kernel_launch(void* const* d_in, const int* in_sizes, int n_in, void* d_out, int out_size, void* d_ws, size_t ws_size, hipStream_t stream) {
    static int grid = 0;
    if (grid == 0) {
        if (n_in != 16 || in_sizes[0] != M * D || out_size != M * D || ws_size < WS_END) { fprintf(stderr, "kernel_launch: unexpected shapes (n_in %d, in0 %d, out %d, ws %zu); nothing launched\n", n_in, n_in > 0 ? in_sizes[0] : -1, out_size, ws_size); grid = -1; return; }
        int dev = 0, cus = 0, per_cu = 0;
        if (hipGetDevice(&dev) != hipSuccess || hipDeviceGetAttribute(&cus, hipDeviceAttributeMultiprocessorCount, dev) != hipSuccess) { fprintf(stderr, "kernel_launch: device query failed\n"); grid = -1; return; }
        if (hipFuncSetAttribute((const void*)mk_fwd, hipFuncAttributeMaxDynamicSharedMemorySize, LDS_BYTES) != hipSuccess) { fprintf(stderr, "kernel_launch: hipFuncSetAttribute failed\n"); grid = -1; return; }
        if (hipOccupancyMaxActiveBlocksPerMultiprocessor(&per_cu, (const void*)mk_fwd, NWAVES * 64, LDS_BYTES) != hipSuccess || per_cu < 1) fprintf(stderr, "kernel_launch: note: occupancy query reports %d workgroups per CU\n", per_cu);
        (void)hipGetLastError();
        grid = cus;
        if (grid != 256) fprintf(stderr, "kernel_launch: %d CUs; the single-unit GEMM phases need exactly 256 workgroups\n", grid);
    }
    if (grid < 0) return;
    if (hipMemsetAsync((char*)d_ws + WS_CTL, 0, CTL_ZERO_BYTES, stream) != hipSuccess) { fprintf(stderr, "kernel_launch: memset failed\n"); return; }
    Args a{};
    for (int i = 0; i < 16; ++i) a.in[i] = (const float*)d_in[i];
    a.out = (float*)d_out; a.ws = (unsigned char*)d_ws;
    if (MK_N_LAUNCHES == 1) { a.ph_lo = 0; a.ph_hi = NPH; hipLaunchKernelGGL(mk_fwd, dim3(grid), dim3(NWAVES * 64), LDS_BYTES, stream, a); }
    else for (int li = 0; li < NPH; ++li) { a.ph_lo = li; a.ph_hi = li + 1; hipLaunchKernelGGL(mk_fwd, dim3(grid), dim3(NWAVES * 64), LDS_BYTES, stream, a); }
    const hipError_t le = hipPeekAtLastError();
    if (le != hipSuccess) fprintf(stderr, "kernel_launch: launch failed: %s\n", hipGetErrorName(le));
}
```

```cpp
#include <hip/hip_runtime.h>
#include <cstdio>
#include <cstdint>
#define LAS __attribute__((address_space(3)))

namespace pg8 {
#define PG8_LAS __attribute__((address_space(3)))
typedef unsigned short bf16_t;
typedef short bf16x8 __attribute__((ext_vector_type(8)));
typedef float f32x4 __attribute__((ext_vector_type(4)));
typedef unsigned u32x4 __attribute__((ext_vector_type(4)));
constexpr int BM = 256, BK = 64, HALF = 128, HTB = HALF * BK * 2  , STAGE_BYTES = 8 * HTB, NXCD = 8, WGM = 8;

__host__ __device__ __forceinline__ int lds_byte(int r, int c) { const int st = (r >> 4) * 2 + (c >> 5), rr = r & 15, cc = c & 31, ob = rr * 64 + cc * 2; return st * 1024 + (ob ^ (((ob >> 9) & 1) << 5)); }
__host__ __device__ __forceinline__ void stage_rc(int b, int& R, int& C) { const int st = b / 1024, sb = b % 1024, swz = sb ^ (((sb >> 9) & 1) << 5); R = (st >> 1) * 16 + swz / 64; C = (st & 1) * 32 + (swz % 64) / 2; }
__host__ __device__ __forceinline__ int perm32(int rho) { const int n = rho >> 4, i = rho & 15; return 8 * (i >> 2) + 4 * n + (i & 3); }

struct Unit { int pm, pn; };
struct Gemm { const bf16_t* A; const bf16_t* Bt; int M, N, K; };

struct StaticOrder {
    int nM, nN, nwg, G, c;
    __host__ __device__ void init(int M, int N, int G_, int c_) { nM = M / BM; nN = N / BM; nwg = nM * nN; G = G_; c = c_; }
    __host__ __device__ bool next(int i, Unit& u) const {
        const long L = (long)i * G + c; if (L >= nwg) return false;
        int wgid = (int)L; { const int q = nwg / NXCD, r = nwg % NXCD, xcd = wgid % NXCD, off = wgid / NXCD; wgid = (xcd < r ? xcd * (q + 1) : r * (q + 1) + (xcd - r) * q) + off; }
        const int nig = WGM * nN, gid = wgid / nig, fm = gid * WGM, gsz = (nM - fm) < WGM ? (nM - fm) : WGM;
        u.pm = fm + ((wgid % nig) % gsz); u.pn = (wgid % nig) / gsz; return true;
    }
    __device__ __forceinline__ void a_ready(const Unit&) const {}
    __device__ __forceinline__ void done(const Unit&) const {}
};

__device__ __forceinline__ unsigned cvt_pk_bf16(float lo, float hi) { unsigned r; asm volatile("v_cvt_pk_bf16_f32 %0, %1, %2" : "=v"(r) : "v"(lo), "v"(hi)); return r; }
template <class Epi, class Sched, bool ALIGN_EPI = false, bool SP2 = false>
__device__ __forceinline__ void gemm_phase(PG8_LAS unsigned char* lds, const Gemm g, const Sched& S, const Epi& E, const int tid_in) {
    int tid_ = tid_in; asm volatile("" : "+v"(tid_));
    const int tid = tid_, wid = __builtin_amdgcn_readfirstlane(tid >> 6), lane = tid & 63, wr = wid >> 2, wc = wid & 3, fr = lane & 15, fq = lane >> 4;
    int K_ = g.K; asm volatile("" : "+s"(K_));
    const int K = K_, nt = K / BK;
    unsigned voffA[2], voffB[2];
#pragma unroll
    for (int i = 0; i < 2; ++i) { int R, C; stage_rc(tid * 16 + i * 8192, R, C); const int Rb = Epi::PERM ? ((R & ~31) + perm32(R & 31)) : R;
        voffA[i] = (unsigned)(R * K + C) * 2u; voffB[i] = (unsigned)(Rb * K + C) * 2u; }
    const size_t kstep = (size_t)(BK * 2);
    const size_t hstep = (size_t)HALF * K * 2;
    const size_t tstep = 2 * hstep;
    const unsigned ldsw = (unsigned)wid * 1024u;
    const int aoff = lds_byte(wr * 64 + fr, fq * 8), boff = lds_byte(wc * 32 + fr, fq * 8);
#define PG8_SA(b, h) (((b) * 2 + (h)) * HTB)
#define PG8_SB(b, h) ((4 + (b) * 2 + (h)) * HTB)
#define PG8_STAGE(bufoff, gbase, voff) do { _Pragma("unroll") for (int _i = 0; _i < 2; ++_i) \
        __builtin_amdgcn_global_load_lds((const unsigned*)((const char*)(gbase) + (voff)[_i]), (PG8_LAS unsigned*)(lds + (bufoff) + ldsw + _i * 8192), 16, 0, 0); } while (0)
#define PG8_LDA(dst, b, h) do { _Pragma("unroll") for (int m = 0; m < 4; ++m) _Pragma("unroll") for (int k = 0; k < 2; ++k) dst[m][k] = *(const PG8_LAS bf16x8*)(lds + PG8_SA(b, h) + aoff + m * 2048 + k * 1024); } while (0)
#define PG8_LDB(dst, b, h) do { _Pragma("unroll") for (int n = 0; n < 2; ++n) _Pragma("unroll") for (int k = 0; k < 2; ++k) dst[n][k] = *(const PG8_LAS bf16x8*)(lds + PG8_SB(b, h) + boff + n * 2048 + k * 1024); } while (0)
#define PG8_MMA(ai, bj, At, Bt) do { __builtin_amdgcn_s_setprio(1); _Pragma("unroll") for (int m = 0; m < 4; ++m) _Pragma("unroll") for (int n = 0; n < 2; ++n) _Pragma("unroll") for (int k = 0; k < 2; ++k) \
        acc[ai][bj][m][n] = __builtin_amdgcn_mfma_f32_16x16x32_bf16(Bt[n][k], At[m][k], acc[ai][bj][m][n], 0, 0, 0); __builtin_amdgcn_s_setprio(0); } while (0)
#define PG8_WAIT_V(n) asm volatile("s_waitcnt vmcnt(" #n ")" ::: "memory")
#define PG8_WAIT_L(n) asm volatile("s_waitcnt lgkmcnt(" #n ")" ::: "memory")
#define PG8_BAR __builtin_amdgcn_s_barrier()
#define PG8_SCHED __builtin_amdgcn_sched_barrier(0)
    Unit cur, nxt; int ui = 0;
    if (!S.next(0, cur)) return;
    f32x4 acc[2][2][4][2];
#pragma unroll
    for (int a = 0; a < 2; ++a)
#pragma unroll
        for (int b = 0; b < 2; ++b)
#pragma unroll
            for (int m = 0; m < 4; ++m)
#pragma unroll
                for (int n = 0; n < 2; ++n) acc[a][b][m][n] = (f32x4){0.f, 0.f, 0.f, 0.f};
    bf16x8 At[4][2], B0[2][2], B1[2][2];
    const char* cA = (const char*)g.A + (size_t)cur.pm * tstep; const char* cB = (const char*)g.Bt + (size_t)cur.pn * tstep;
    S.a_ready(cur);
    if constexpr (SP2) {
        PG8_STAGE(PG8_SB(0, 0), cB, voffB); PG8_STAGE(PG8_SB(0, 1), cB + hstep, voffB); PG8_STAGE(PG8_SA(0, 0), cA, voffA); PG8_STAGE(PG8_SA(0, 1), cA + hstep, voffA);
        if (wr == 1) PG8_BAR;
        PG8_WAIT_V(2); PG8_BAR;
        PG8_STAGE(PG8_SB(1, 0), cB + kstep, voffB); PG8_STAGE(PG8_SA(1, 0), cA + kstep, voffA); PG8_STAGE(PG8_SB(1, 1), cB + hstep + kstep, voffB);
        PG8_WAIT_V(6); PG8_BAR;
    } else {
        PG8_STAGE(PG8_SB(0, 0), cB, voffB); PG8_STAGE(PG8_SA(0, 0), cA, voffA); PG8_STAGE(PG8_SB(0, 1), cB + hstep, voffB); PG8_STAGE(PG8_SA(0, 1), cA + hstep, voffA);
        if (wr == 1) PG8_BAR;
        PG8_WAIT_V(4); PG8_BAR;
        PG8_STAGE(PG8_SB(1, 0), cB + kstep, voffB); PG8_STAGE(PG8_SA(1, 0), cA + kstep, voffA); PG8_STAGE(PG8_SB(1, 1), cB + hstep + kstep, voffB);
        PG8_WAIT_V(6); PG8_BAR;
    }
    for (;;) {
        const bool has_next = S.next(ui + 1, nxt);
        const char* nA = has_next ? (const char*)g.A + (size_t)nxt.pm * tstep : cA; const char* nB = has_next ? (const char*)g.Bt + (size_t)nxt.pn * tstep : cB;
        for (int t = 0; t < nt; t += 2) {
            const bool last = (t == nt - 2);
            if constexpr (Epi::MIDSCALE) { if (t == (nt >> 1)) E.mid(acc, cur, wr, wc, fr, fq); }
            const char* a1 = cA + (size_t)(t + 1) * kstep;
            const char* a2 = last ? nA : cA + (size_t)(t + 2) * kstep; const char* b2 = last ? nB : cB + (size_t)(t + 2) * kstep;
            const char* a3 = a2 + kstep; const char* b3 = b2 + kstep;
            if (last && has_next) S.a_ready(nxt);
            if constexpr (SP2) {
            PG8_LDB(B0, 0, 0); PG8_LDB(B1, 0, 1); PG8_SCHED; PG8_LDA(At, 0, 0); PG8_STAGE(PG8_SA(1, 1), a1 + hstep, voffA);
            PG8_WAIT_V(8); PG8_WAIT_L(0); PG8_BAR; PG8_MMA(0, 0, At, B0); PG8_MMA(0, 1, At, B1); PG8_BAR; PG8_SCHED;
            PG8_LDA(At, 0, 1); PG8_STAGE(PG8_SB(0, 0), b2, voffB); PG8_STAGE(PG8_SB(0, 1), b2 + hstep, voffB); PG8_STAGE(PG8_SA(0, 0), a2, voffA);
            PG8_WAIT_V(8); PG8_WAIT_L(0); PG8_BAR; PG8_MMA(1, 0, At, B0); PG8_MMA(1, 1, At, B1); PG8_BAR; PG8_SCHED;
            PG8_LDB(B0, 1, 0); PG8_LDB(B1, 1, 1); PG8_SCHED; PG8_LDA(At, 1, 0); PG8_STAGE(PG8_SA(0, 1), a2 + hstep, voffA);
            PG8_WAIT_V(8); PG8_WAIT_L(0); PG8_BAR; PG8_MMA(0, 0, At, B0); PG8_MMA(0, 1, At, B1); PG8_BAR; PG8_SCHED;
            PG8_LDA(At, 1, 1); PG8_STAGE(PG8_SB(1, 0), b3, voffB); PG8_STAGE(PG8_SB(1, 1), b3 + hstep, voffB); PG8_STAGE(PG8_SA(1, 0), a3, voffA);
            PG8_WAIT_V(8); PG8_WAIT_L(0); PG8_BAR; PG8_MMA(1, 0, At, B0); PG8_MMA(1, 1, At, B1); PG8_BAR; PG8_SCHED;
            } else {
            PG8_LDB(B0, 0, 0); PG8_SCHED; PG8_LDA(At, 0, 0); PG8_STAGE(PG8_SA(1, 1), a1 + hstep, voffA);
            PG8_WAIT_L(8); PG8_BAR; PG8_WAIT_L(0); PG8_MMA(0, 0, At, B0); PG8_BAR; PG8_SCHED;
            PG8_LDB(B1, 0, 1); PG8_STAGE(PG8_SB(0, 0), b2, voffB);
            PG8_BAR; PG8_WAIT_L(0); PG8_MMA(0, 1, At, B1); PG8_BAR;
            PG8_LDA(At, 0, 1); PG8_STAGE(PG8_SA(0, 0), a2, voffA);
            PG8_BAR; PG8_WAIT_L(0); PG8_MMA(1, 0, At, B0); PG8_BAR; PG8_SCHED;
            PG8_STAGE(PG8_SB(0, 1), b2 + hstep, voffB);
            PG8_WAIT_V(6); PG8_BAR; PG8_MMA(1, 1, At, B1); PG8_BAR;
            PG8_LDB(B0, 1, 0); PG8_SCHED; PG8_LDA(At, 1, 0); PG8_STAGE(PG8_SA(0, 1), a2 + hstep, voffA);
            PG8_WAIT_L(8); PG8_BAR; PG8_WAIT_L(0); PG8_MMA(0, 0, At, B0); PG8_BAR; PG8_SCHED;
            PG8_LDB(B1, 1, 1); PG8_STAGE(PG8_SB(1, 0), b3, voffB);
            PG8_BAR; PG8_WAIT_L(0); PG8_MMA(0, 1, At, B1); PG8_BAR;
            PG8_LDA(At, 1, 1); PG8_STAGE(PG8_SA(1, 0), a3, voffA);
            PG8_BAR; PG8_WAIT_L(0); PG8_MMA(1, 0, At, B0); PG8_BAR; PG8_SCHED;
            PG8_STAGE(PG8_SB(1, 1), b3 + hstep, voffB);
            PG8_WAIT_V(6); PG8_BAR; PG8_MMA(1, 1, At, B1); PG8_BAR;
            }
        }
        if constexpr (ALIGN_EPI) { if (wr == 0) PG8_BAR; }
        if constexpr (!Epi::AFTER_DRAIN) { E(acc, cur, wr, wc, fr, fq); S.done(cur); }
        if (!has_next) break;
#pragma unroll
        for (int a = 0; a < 2; ++a)
#pragma unroll
            for (int b = 0; b < 2; ++b)
#pragma unroll
                for (int m = 0; m < 4; ++m)
#pragma unroll
                    for (int n = 0; n < 2; ++n) acc[a][b][m][n] = (f32x4){0.f, 0.f, 0.f, 0.f};
        cur = nxt; cA = nA; cB = nB; ++ui;
        if constexpr (ALIGN_EPI) { if (wr == 1) PG8_BAR; }
    }
    PG8_WAIT_V(0);
    if constexpr (!ALIGN_EPI) { if (wr == 0) PG8_BAR; }
    PG8_BAR;
    if constexpr (Epi::AFTER_DRAIN) { E.fused(acc, cur, wr, wc, fr, fq, lds, wid, lane); S.done(cur); }
#undef PG8_SA
#undef PG8_SB
#undef PG8_STAGE
#undef PG8_LDA
#undef PG8_LDB
#undef PG8_MMA
#undef PG8_WAIT_V
#undef PG8_WAIT_L
#undef PG8_BAR
#undef PG8_SCHED
}
}

#define XB_TMO      128
#define XB_XCNT(j)  (256  + 64 * (j))
#define XB_XSUB(j)  (1280 + 64 * (j))
#define XB_XGEN(j)  (2304 + 64 * (j))
#define XB_TOP      3328
#define XB_TOPGEN   3392
#define XCD_BAR_WORDS 3456
#define XB_SPIN_CAP (1u << 18)

__device__ __forceinline__ unsigned xb_ld(unsigned* p)              { return __hip_atomic_load(p, __ATOMIC_RELAXED, __HIP_MEMORY_SCOPE_AGENT); }
__device__ __forceinline__ unsigned xb_add(unsigned* p, unsigned v) { return __hip_atomic_fetch_add(p, v, __ATOMIC_RELAXED, __HIP_MEMORY_SCOPE_AGENT); }
__device__ __forceinline__ unsigned xb_xcc_id() { return (unsigned)__builtin_amdgcn_s_getreg((3 << 11) | 20) & 0xFu; }
#define XB_SPIN(cond, bar) do { unsigned _sp = 0; while (cond) { __builtin_amdgcn_s_sleep(1); \
    if ((++_sp & 255u) == 0u) { if (xb_ld(&(bar)[XB_TMO])) break; if (_sp > XB_SPIN_CAP) { atomicAdd(&(bar)[XB_TMO], 1u); break; } } } } while (0)

struct XcdBarrier {
    unsigned* bar; unsigned x;
    volatile LAS unsigned* st;
};

__device__ __forceinline__ XcdBarrier xcd_barrier_post(unsigned* bar, volatile LAS unsigned* st) {
    XcdBarrier b; b.bar = bar; b.x = xb_xcc_id(); b.st = st;
    if (threadIdx.x == 0) (void)xb_add(&bar[XB_XCNT(b.x)], 1u);
    return b;
}
__device__ __forceinline__ void xcd_barrier_complete(unsigned* bar, unsigned x, unsigned& nloc, unsigned& nx) {
    const unsigned G = gridDim.x * gridDim.y * gridDim.z;
    unsigned sum, cnt, mine, sp = 0u;
    for (;;) {
        sum = 0u; cnt = 0u; mine = 0u;
#pragma unroll
        for (unsigned j = 0; j < 16; ++j) { const unsigned c = xb_ld(&bar[XB_XCNT(j)]); sum += c; cnt += (c > 0u) ? 1u : 0u; mine = (j == x) ? c : mine; }
        if (sum == G) break;
        __builtin_amdgcn_s_sleep(1);
        if ((++sp & 255u) == 0u) { if (xb_ld(&bar[XB_TMO])) break; if (sp > XB_SPIN_CAP) { atomicAdd(&bar[XB_TMO], 1u); break; } }
    }
    nloc = mine > 0u ? mine : 1u; nx = cnt > 0u ? cnt : 1u;
}

__device__ __forceinline__ void xcd_barrier(const XcdBarrier& b, const bool is_t0  ) {
    asm volatile("s_waitcnt vmcnt(0)" ::: "memory");
    __syncthreads();
    if (is_t0) {
        unsigned* bar = b.bar;
        __builtin_amdgcn_s_waitcnt(0);
        unsigned nloc = b.st[0], nx = b.st[1];
        if (nloc == 0u) { xcd_barrier_complete(bar, b.x, nloc, nx); b.st[0] = nloc; b.st[1] = nx; }
        const unsigned old = xb_add(&bar[XB_XSUB(b.x)], 1u);
        const unsigned gen = old / nloc;
        if (old + 1u == (gen + 1u) * nloc) {
            __builtin_amdgcn_fence(__ATOMIC_RELEASE, "agent");
            asm volatile("s_waitcnt vmcnt(0)" ::: "memory");
            const unsigned og = xb_add(&bar[XB_TOP], 1u);
            const unsigned tg = og / nx;
            if (og + 1u == (tg + 1u) * nx) xb_add(&bar[XB_TOPGEN], 1u);
            else XB_SPIN(xb_ld(&bar[XB_TOPGEN]) == tg, bar);
            __builtin_amdgcn_fence(__ATOMIC_ACQUIRE, "agent");
            xb_add(&bar[XB_XGEN(b.x)], 1u);
            asm volatile("s_waitcnt vmcnt(0)" ::: "memory");
        } else {
            XB_SPIN(xb_ld(&bar[XB_XGEN(b.x)]) == gen, bar);
            __builtin_amdgcn_fence(__ATOMIC_ACQUIRE, "agent");
            asm volatile("s_waitcnt vmcnt(0)" ::: "memory");
        }
    }
    __syncthreads();
}


typedef unsigned short bf16;
typedef short bf16x8 __attribute__((ext_vector_type(8)));
typedef float f32x4 __attribute__((ext_vector_type(4)));
typedef unsigned u32x4 __attribute__((ext_vector_type(4)));
typedef unsigned u32x2 __attribute__((ext_vector_type(2)));
#define GAS __attribute__((address_space(1)))
#define DI __device__ __forceinline__

constexpr int BATCH = 4, SEQ = 4096, D = 1024, DEPTH = 2;
constexpr int M = BATCH * SEQ;
constexpr int NIN = 4352, FF = 4096, PLE = 256;
constexpr int NQKV = 2304, NGATE = 2048;
constexpr float EPS = 1e-6f;
constexpr float LOG2E = 1.4426950408889634f;
constexpr float C2 = 0.125f * LOG2E;
constexpr int NWAVES = 8;

constexpr size_t MiB = 1u << 20;
constexpr size_t WS_CTL = 0, CTL_ZERO_BYTES = 64 * 1024;
constexpr size_t WS_WIN = 1 * MiB;
constexpr size_t WS_WUP = WS_WIN + (size_t)NIN * D * 2;
constexpr size_t WS_WO = WS_WUP + 2 * MiB;
constexpr size_t WS_WFF1 = WS_WO + 2 * MiB;
constexpr size_t WS_WFF2 = WS_WFF1 + 8 * MiB;
constexpr size_t WS_WPE = WS_WFF2 + 8 * MiB;
constexpr size_t WS_WPG = WS_WPE + MiB / 2;
constexpr size_t WS_SS = 32 * MiB;
constexpr size_t WS_BT = 33 * MiB;
constexpr size_t WS_PB = 34 * MiB;
constexpr size_t WS_XB = 50 * MiB;
constexpr size_t WS_ATT = 82 * MiB;
constexpr size_t WS_QKV = 114 * MiB;
constexpr size_t WS_GATE = 186 * MiB;
constexpr size_t WS_MRG = WS_QKV;
constexpr size_t WS_U = WS_QKV;
constexpr size_t WS_PE = WS_ATT;
constexpr size_t WS_END = 250 * MiB;
static_assert(WS_WPG + 2 * MiB <= WS_SS && WS_U + (size_t)M * FF * 2 <= WS_END && WS_GATE + (size_t)M * NGATE * 2 <= WS_END, "ws map");
constexpr int CW_BAR = 4096;

constexpr int RING_BYTES = 131072;
constexpr int MISC_OFF = RING_BYTES + 320;
constexpr int LDS_BYTES = 147456;

DI unsigned f2bf(float f) { unsigned u = __builtin_bit_cast(unsigned, f); return (u + 0x7fffu + ((u >> 16) & 1u)) >> 16; }
DI unsigned pk2(float lo, float hi) { return f2bf(lo) | (f2bf(hi) << 16); }
typedef float f32x2_t __attribute__((ext_vector_type(2))); typedef __bf16 bf16x2_t __attribute__((ext_vector_type(2)));
DI unsigned cvtpk(float lo, float hi) { f32x2_t v = {lo, hi}; bf16x2_t b = __builtin_convertvector(v, bf16x2_t); return __builtin_bit_cast(unsigned, b); }
DI u32x4 pack8(f32x4 a, f32x4 b) { u32x4 w; w.x = cvtpk(a[0], a[1]); w.y = cvtpk(a[2], a[3]); w.z = cvtpk(b[0], b[1]); w.w = cvtpk(b[2], b[3]); return w; }
DI void unpack8(u32x4 w, f32x4& a, f32x4& b) {
    a = (f32x4){__builtin_bit_cast(float, w.x << 16), __builtin_bit_cast(float, w.x & 0xffff0000u), __builtin_bit_cast(float, w.y << 16), __builtin_bit_cast(float, w.y & 0xffff0000u)};
    b = (f32x4){__builtin_bit_cast(float, w.z << 16), __builtin_bit_cast(float, w.z & 0xffff0000u), __builtin_bit_cast(float, w.w << 16), __builtin_bit_cast(float, w.w & 0xffff0000u)}; }
template <int X> DI float swz_xor(float v) { return __builtin_bit_cast(float, __builtin_amdgcn_ds_swizzle(__builtin_bit_cast(int, v), (X << 10) | 0x1f)); }
DI float sum_halves(float v) { auto rr = __builtin_amdgcn_permlane32_swap(__float_as_uint(v), __float_as_uint(v), false, false); return __uint_as_float(rr[0]) + __uint_as_float(rr[1]); }
DI float wave_sum(float v) { v += swz_xor<1>(v); v += swz_xor<2>(v); v += swz_xor<4>(v); v += swz_xor<8>(v); v += swz_xor<16>(v); return sum_halves(v); }
DI float rs_from(f32x4 s) { return 1.0f / sqrtf(((s[0] + s[1]) + (s[2] + s[3])) * (1.0f / D) + EPS); }
DI float sigm(float v) { return 1.0f / (1.0f + __expf(-v)); }
#define MEMFENCE() asm volatile("" ::: "memory")

using pg8::Unit;
constexpr int HALF = 128;
DI void load_rs8(const float* SS, int row0, float (&rs)[2][4]) {
    f32x4 s[2][4];
#pragma unroll
    for (int ai = 0; ai < 2; ++ai)
#pragma unroll
        for (int m = 0; m < 4; ++m) s[ai][m] = *(const f32x4*)(SS + (size_t)(row0 + ai * HALF + m * 16) * 4);
#pragma unroll
    for (int ai = 0; ai < 2; ++ai)
#pragma unroll
        for (int m = 0; m < 4; ++m) rs[ai][m] = rs_from(s[ai][m]);
}

struct EpiIn {
    static constexpr bool PERM = true, AFTER_DRAIN = false, MIDSCALE = false;
    const float* SS; bf16* QKV; bf16* GATE;
    DI void operator()(const f32x4 (&acc)[2][2][4][2], const Unit& u, int wr, int wc, int fr, int fq) const {
        const int row0 = u.pm * 256 + wr * 64 + fr;
        float rs[2][4]; load_rs8(SS, row0, rs);
        if (u.pn < 9) {
            const float cs = (u.pn < 2 || u.pn == 6 || u.pn == 7) ? C2 : 1.0f;
            const int col0 = u.pn * 256 + wc * 32 + 8 * fq;
#pragma unroll
            for (int ai = 0; ai < 2; ++ai)
#pragma unroll
                for (int m = 0; m < 4; ++m) { const float sc = rs[ai][m] * cs; bf16* rowp = QKV + (size_t)(row0 + ai * HALF + m * 16) * NQKV + col0;
#pragma unroll
                    for (int bj = 0; bj < 2; ++bj) *(u32x4*)(rowp + bj * HALF) = pack8(acc[ai][bj][m][0] * sc, acc[ai][bj][m][1] * sc); }
        } else {
            const int c0 = (u.pn - 9) * 128 + wc * 32 + 8 * fq;
#pragma unroll
            for (int ai = 0; ai < 2; ++ai)
#pragma unroll
                for (int m = 0; m < 4; ++m) { const float r = rs[ai][m]; bf16* rowp = GATE + (size_t)(row0 + ai * HALF + m * 16) * NGATE + c0;
                    f32x4 ra[2], gb[2];
#pragma unroll
                    for (int n = 0; n < 2; ++n)
#pragma unroll
                        for (int j = 0; j < 4; ++j) { const float ea = fminf(__expf(-acc[ai][0][m][n][j] * r), 1e30f), eb = fminf(__expf(-acc[ai][1][m][n][j] * r), 1e30f);
                            const float g = 1.0f / (1.0f + eb); gb[n][j] = g; ra[n][j] = (1.0f + eb) / (1.0f + ea); }
                    *(u32x4*)rowp = pack8(ra[0], ra[1]); *(u32x4*)(rowp + 1024) = pack8(gb[0], gb[1]); }
        }
    }
};
struct EpiUp {
    static constexpr bool PERM = true, AFTER_DRAIN = false, MIDSCALE = true;
    const bf16* GATE; bf16* MRG;
    DI void mid(f32x4 (&acc)[2][2][4][2], const Unit& u, int wr, int wc, int fr, int fq) const {
        const int row0 = u.pm * 256 + wr * 64 + fr, col0 = u.pn * 256 + wc * 32 + 8 * fq;
#pragma unroll
        for (int ai = 0; ai < 2; ++ai)
#pragma unroll
            for (int m = 0; m < 4; ++m) { const bf16* rowp = GATE + (size_t)(row0 + ai * HALF + m * 16) * NGATE + col0;
#pragma unroll
                for (int bj = 0; bj < 2; ++bj) { f32x4 a, b; unpack8(*(const u32x4*)(rowp + bj * HALF), a, b); acc[ai][bj][m][0] *= a; acc[ai][bj][m][1] *= b; }
                MEMFENCE(); }
    }
    DI void operator()(const f32x4 (&acc)[2][2][4][2], const Unit& u, int wr, int wc, int fr, int fq) const {
        const int row0 = u.pm * 256 + wr * 64 + fr, col0 = u.pn * 256 + wc * 32 + 8 * fq;
#pragma unroll
        for (int ai = 0; ai < 2; ++ai)
#pragma unroll
            for (int m = 0; m < 4; ++m) { const size_t r = (size_t)(row0 + ai * HALF + m * 16);
#pragma unroll
                for (int bj = 0; bj < 2; ++bj) { f32x4 a, b; unpack8(*(const u32x4*)(GATE + r * NGATE + 1024 + col0 + bj * HALF), a, b);
                    *(u32x4*)(MRG + r * D + col0 + bj * HALF) = pack8(acc[ai][bj][m][0] * a, acc[ai][bj][m][1] * b); }
                if (m & 1) MEMFENCE(); }
    }
};
struct EpiFf1 {
    static constexpr bool PERM = true, AFTER_DRAIN = false, MIDSCALE = false;
    const float* SS; bf16* U;
    DI void operator()(const f32x4 (&acc)[2][2][4][2], const Unit& u, int wr, int wc, int fr, int fq) const {
        const int row0 = u.pm * 256 + wr * 64 + fr, col0 = u.pn * 256 + wc * 32 + 8 * fq;
        float rs[2][4]; load_rs8(SS, row0, rs);
#pragma unroll
        for (int ai = 0; ai < 2; ++ai)
#pragma unroll
            for (int m = 0; m < 4; ++m) { const float r = rs[ai][m]; bf16* rowp = U + (size_t)(row0 + ai * HALF + m * 16) * FF + col0;
#pragma unroll
                for (int bj = 0; bj < 2; ++bj) { f32x4 v0 = acc[ai][bj][m][0] * r, v1 = acc[ai][bj][m][1] * r;
#pragma unroll
                    for (int j = 0; j < 4; ++j) { const float a = fmaxf(v0[j], 0.f), b = fmaxf(v1[j], 0.f); v0[j] = a * a; v1[j] = b * b; }
                    *(u32x4*)(rowp + bj * HALF) = pack8(v0, v1); } }
    }
};
struct EpiPe {
    static constexpr bool PERM = true, AFTER_DRAIN = false, MIDSCALE = false;
    bf16* PE;
    DI void operator()(const f32x4 (&acc)[2][2][4][2], const Unit& u, int wr, int wc, int fr, int fq) const {
        const int row0 = u.pm * 256 + wr * 64 + fr, col0 = u.pn * 256 + wc * 32 + 8 * fq;
#pragma unroll
        for (int ai = 0; ai < 2; ++ai)
#pragma unroll
            for (int m = 0; m < 4; ++m) { bf16* rowp = PE + (size_t)(row0 + ai * HALF + m * 16) * D + col0;
#pragma unroll
                for (int bj = 0; bj < 2; ++bj) *(u32x4*)(rowp + bj * HALF) = pack8(acc[ai][bj][m][0], acc[ai][bj][m][1]); }
    }
};
template <bool GATED, bool XF32> struct EpiRes {
    static constexpr bool PERM = true, AFTER_DRAIN = true, MIDSCALE = false;
    const float* xin32; const bf16* xin16; bf16* XBout; float* SS; const bf16* PE; const float* SSr; bool dry; XcdBarrier bar;
    DI void fused(f32x4 (&acc)[2][2][4][2], const Unit& u, int wr, int wc, int fr, int fq, LAS unsigned char* lds, int wid, int lane) const {
        const int row0 = u.pm * 256 + wr * 64 + fr, col0 = u.pn * 256 + wc * 32 + 8 * fq;
        LAS float* P = (LAS float*)lds;
        float rs[2][4];
        if (GATED) { load_rs8(SSr, row0, rs); xcd_barrier(bar, wid == 0 && lane == 0); }
#pragma unroll
        for (int ai = 0; ai < 2; ++ai)
#pragma unroll
            for (int m = 0; m < 4; ++m) { const size_t r = (size_t)(row0 + ai * HALF + m * 16); float ss = 0.f;
#pragma unroll
                for (int bj = 0; bj < 2; ++bj) { const size_t o = r * D + col0 + bj * HALF;
                    f32x4 x0, x1, v0 = acc[ai][bj][m][0], v1 = acc[ai][bj][m][1];
                    if (XF32) { x0 = *(const f32x4*)(xin32 + o); x1 = *(const f32x4*)(xin32 + o + 4); } else unpack8(*(const u32x4*)(xin16 + o), x0, x1);
                    if (GATED) { f32x4 p0, p1; unpack8(*(const u32x4*)(PE + o), p0, p1); const float rr = rs[ai][m];
#pragma unroll
                        for (int j = 0; j < 4; ++j) { v0[j] = p0[j] * sigm(v0[j] * rr); v1[j] = p1[j] * sigm(v1[j] * rr); } }
                    x0 += v0; x1 += v1;
                    if (!dry) *(u32x4*)(XBout + o) = pack8(x0, x1);
                    ss += ((x0[0] * x0[0] + x0[1] * x0[1]) + (x0[2] * x0[2] + x0[3] * x0[3])) + ((x1[0] * x1[0] + x1[1] * x1[1]) + (x1[2] * x1[2] + x1[3] * x1[3])); }
                ss += swz_xor<16>(ss); ss = sum_halves(ss);
                if (fq == 0) P[(ai * HALF + wr * 64 + m * 16 + fr) * 4 + wc] = ss;
                if (m & 1) MEMFENCE(); }
        __syncthreads();
        if (wid < 4 && !dry) { const int row = wid * 64 + lane; const f32x4 p = *(const LAS f32x4*)(P + row * 4);
            SS[(size_t)(u.pm * 256 + row) * 4 + u.pn] = (p[0] + p[1]) + (p[2] + p[3]); }
        __syncthreads();
    }
};


namespace att {
typedef short s16x4 __attribute__((ext_vector_type(4)));
typedef float f32x16 __attribute__((ext_vector_type(16)));
typedef LAS const char* lds_cptr;
#define SBAR() __builtin_amdgcn_sched_barrier(0)
#define MFMA32(a, b, c) __builtin_amdgcn_mfma_f32_32x32x16_bf16((a), (b), (c), 0, 0, 0)
DI int crow(int r, int hi) { return (r & 3) + 8 * (r >> 2) + 4 * hi; }
DI void qkt(f32x16& p0, f32x16& p1, lds_cptr Kslot, const bf16x8* qr, int r32, int hi) {
    const lds_cptr kb = Kslot + hi * 1024 + r32 * 16;
    f32x16 z0 = {}, z1 = {};
#pragma unroll
    for (int d0 = 0; d0 < 4; ++d0) {
        const bf16x8 b0 = *(const LAS bf16x8*)(kb + d0 * 2048), b1 = *(const LAS bf16x8*)(kb + d0 * 2048 + 512);
        z0 = MFMA32(b0, qr[d0], z0); z1 = MFMA32(b1, qr[d0], z1); }
    p0 = z0; p1 = z1;
}
DI void pv(f32x16* o, int vb, bf16x8 pa0, bf16x8 pa1, bf16x8 pa2, bf16x8 pa3) {
#pragma unroll
    for (int d0 = 0; d0 < 2; ++d0) { s16x4 lo[4], hi[4];
#pragma unroll
        for (int ks = 0; ks < 4; ++ks) {
            asm volatile("ds_read_b64_tr_b16 %0,%1 offset:%c2" : "=&v"(lo[ks]) : "v"(vb), "i"(d0 * 4096 + ks * 1024) : "memory");
            asm volatile("ds_read_b64_tr_b16 %0,%1 offset:%c2" : "=&v"(hi[ks]) : "v"(vb), "i"(d0 * 4096 + ks * 1024 + 512) : "memory"); }
        asm volatile("s_waitcnt lgkmcnt(0)" ::: "memory"); SBAR();
#define PK(k) (bf16x8){lo[k][0], lo[k][1], lo[k][2], lo[k][3], hi[k][0], hi[k][1], hi[k][2], hi[k][3]}
        o[d0] = MFMA32(pa0, PK(0), o[d0]); o[d0] = MFMA32(pa1, PK(1), o[d0]); o[d0] = MFMA32(pa2, PK(2), o[d0]); o[d0] = MFMA32(pa3, PK(3), o[d0]);
#undef PK
    }
}
DI int vlane_ofs(int lane, int hi) { return ((lane >> 4) & 1) * 32 + (lane & 3) * 8 + (4 * hi + ((lane & 15) >> 2)) * 64; }
DI float other_half(float v, int hi) { auto rr = __builtin_amdgcn_permlane32_swap(__float_as_uint(v), __float_as_uint(v), false, false); return __uint_as_float(hi ? rr[0] : rr[1]); }
DI void pack_p(const f32x16& p0, const f32x16& p1, u32x4& w0, u32x4& w1, u32x4& w2, u32x4& w3) {
    w0 = (u32x4){cvtpk(p0[0], p0[1]), cvtpk(p0[2], p0[3]), cvtpk(p0[4], p0[5]), cvtpk(p0[6], p0[7])};
    w1 = (u32x4){cvtpk(p0[8], p0[9]), cvtpk(p0[10], p0[11]), cvtpk(p0[12], p0[13]), cvtpk(p0[14], p0[15])};
    w2 = (u32x4){cvtpk(p1[0], p1[1]), cvtpk(p1[2], p1[3]), cvtpk(p1[4], p1[5]), cvtpk(p1[6], p1[7])};
    w3 = (u32x4){cvtpk(p1[8], p1[9]), cvtpk(p1[10], p1[11]), cvtpk(p1[12], p1[13]), cvtpk(p1[14], p1[15])};
}
DI void store_o(const f32x16* o, const float* scale, LAS bf16* stg, bf16* Ow, int pitch, int lane, int r32, int hi) {
#pragma unroll
    for (int r = 0; r < 16; ++r) { const int orow = crow(r, hi); const float sc = scale ? scale[r] : 1.0f;
#pragma unroll
        for (int d0 = 0; d0 < 2; ++d0) stg[orow * 64 + d0 * 32 + r32] = (bf16)f2bf(o[d0][r] * sc); }
    asm volatile("s_waitcnt lgkmcnt(0)" ::: "memory");
#pragma unroll
    for (int i = 0; i < 4; ++i) { const int row = i * 8 + (lane >> 3), ch = lane & 7; const u32x4 v = *(const LAS u32x4*)(stg + row * 64 + ch * 8); *(u32x4*)(Ow + (long)row * pitch + ch * 8) = v; }
}

DI void sb_half(f32x16& p, float& T, int kb, int qabs, bool need_mask, int hi, float oth) {
    f32x16 lb;
#pragma unroll
    for (int r = 0; r < 16; ++r) { const float y = p[r], L = __builtin_amdgcn_logf(1.0f + __builtin_amdgcn_exp2f(-__builtin_fabsf(y))); lb[r] = __builtin_fminf(y, 0.f) - L; p[r] = __builtin_fminf(-y, 0.f) - L; }
    if (need_mask) {
#pragma unroll
        for (int r = 0; r < 16; ++r) { const int key = kb + (r & 3) + 8 * (r >> 2); if (key >= qabs) { p[r] = 0.f; lb[r] = -INFINITY; } } }
    float gs[4], og[4];
#pragma unroll
    for (int g = 0; g < 4; ++g) gs[g] = (p[4 * g] + p[4 * g + 1]) + (p[4 * g + 2] + p[4 * g + 3]);
#pragma unroll
    for (int g = 0; g < 4; ++g) og[g] = other_half(gs[g], hi);
#pragma unroll
    for (int g = 3; g >= 0; --g) { float S = T + oth * og[g]; T += gs[g] + og[g];
        const float a3 = __builtin_amdgcn_exp2f(lb[4 * g + 3] + S); S += p[4 * g + 3];
        const float a2 = __builtin_amdgcn_exp2f(lb[4 * g + 2] + S); S += p[4 * g + 2];
        const float a1 = __builtin_amdgcn_exp2f(lb[4 * g + 1] + S); S += p[4 * g + 1];
        const float a0 = __builtin_amdgcn_exp2f(lb[4 * g] + S);
        p[4 * g] = a0; p[4 * g + 1] = a1; p[4 * g + 2] = a2; p[4 * g + 3] = a3; }
}
DI void sb_math(f32x16& p0, f32x16& p1, float& carry, int kb, int qabs, bool need_mask, int hi) {
    const float oth = hi ? 0.f : 1.f;
    float T = carry;
    sb_half(p1, T, kb + 32, qabs, need_mask, hi, oth);
    sb_half(p0, T, kb, qabs, need_mask, hi, oth);
    carry = T;
}
constexpr float SB_DONE = -152.0f;
DI void load_k(bf16x8 (&kf)[8], const bf16* ksrc, int jt) {
    const bf16* p = ksrc + (long)jt * 64 * NQKV;
#pragma unroll
    for (int d0 = 0; d0 < 4; ++d0) { kf[2 * d0] = *(const bf16x8*)(p + 16 * d0); kf[2 * d0 + 1] = *(const bf16x8*)(p + (long)32 * NQKV + 16 * d0); }
}
DI void load_v(u32x4 (&vr)[8], const bf16* vsrc, int jt) {
    const bf16* p = vsrc + (long)jt * 64 * NQKV;
#pragma unroll
    for (int i = 0; i < 8; ++i) vr[i] = *(const u32x4*)(p + (long)(16 * (i & 3)) * NQKV + 32 * (i >> 2));
}
DI void dma_v(const bf16* vsrc, int jt, LAS char* slot) {
    const bf16* p = vsrc + (long)jt * 64 * NQKV;
#pragma unroll
    for (int i = 0; i < 8; ++i) __builtin_amdgcn_global_load_lds((const GAS unsigned*)(p + (long)(16 * (i & 3)) * NQKV + 32 * (i >> 2)), (LAS unsigned*)(slot + i * 1024), 16, 0, 0);
}
DI void store_v(const u32x4 (&vr)[8], LAS char* slot, int lane) {
#pragma unroll
    for (int i = 0; i < 8; ++i) *(LAS u32x4*)(slot + i * 1024 + lane * 16) = vr[i];
}
DI void qkt_r(f32x16& p0, f32x16& p1, const bf16x8 (&kf)[8], const bf16x8* qr) {
    f32x16 z0 = {}, z1 = {};
#pragma unroll
    for (int d0 = 0; d0 < 4; ++d0) { z0 = MFMA32(kf[2 * d0], qr[d0], z0); z1 = MFMA32(kf[2 * d0 + 1], qr[d0], z1); }
    p0 = z0; p1 = z1;
}
template <bool EARLY> DI void sbw_unit(int b, int h, int qb32, const bf16* QKV, bf16* ATT, LAS char* wl, int lane) {
    const int r32 = lane & 31, hi = lane >> 5;
    const long rowbase = (long)b * SEQ; const int qs = qb32 * 32, qabs = qs + r32;
    const bf16* Qw = QKV + (rowbase + qs) * NQKV + h * 64;
    const bf16* ksrc = QKV + rowbase * NQKV + 512 + h * 64 + (long)r32 * NQKV + hi * 8;
    const bf16* vsrc = QKV + rowbase * NQKV + 1024 + h * 64 + (long)(lane >> 2) * NQKV + (lane & 3) * 8;
    bf16x8 qr[4];
#pragma unroll
    for (int d0 = 0; d0 < 4; ++d0) qr[d0] = *(const bf16x8*)(Qw + (long)r32 * NQKV + d0 * 16 + hi * 8);
    f32x16 o[2]; o[0] = f32x16{}; o[1] = f32x16{};
    float carry = 0.f;
    int jt = (qs + 31) >> 6, slot = 0;
    const int vofs = (int)(uintptr_t)wl + vlane_ofs(lane, hi);
    bf16x8 kf[8];
    load_k(kf, ksrc, jt); dma_v(vsrc, jt, wl);
    for (;;) {
        f32x16 p0, p1; qkt_r(p0, p1, kf, qr);
        if (jt > 0) { load_k(kf, ksrc, jt - 1); dma_v(vsrc, jt - 1, wl + (slot ^ 1) * 8192); }
        sb_math(p0, p1, carry, 64 * jt + 4 * hi, qabs, 64 * jt + 63 >= qs, hi);
        u32x4 w0, w1, w2, w3; pack_p(p0, p1, w0, w1, w2, w3);
        if (jt > 0) asm volatile("s_waitcnt vmcnt(16)" ::: "memory"); else asm volatile("s_waitcnt vmcnt(0)" ::: "memory");
        pv(o, vofs + slot * 8192, __builtin_bit_cast(bf16x8, w0), __builtin_bit_cast(bf16x8, w1), __builtin_bit_cast(bf16x8, w2), __builtin_bit_cast(bf16x8, w3));
        bool done = jt == 0;
        if (EARLY) done = done || (__all(carry < SB_DONE) != 0);
        if (done) break;
        slot ^= 1; --jt;
    }
    asm volatile("s_waitcnt vmcnt(0)" ::: "memory");
    asm volatile("s_waitcnt lgkmcnt(0)" ::: "memory");
    store_o(o, nullptr, (LAS bf16*)wl, ATT + (rowbase + qs) * D + h * 64, D, lane, r32, hi);
    asm volatile("s_waitcnt lgkmcnt(0)" ::: "memory");
}

DI void swaw_unit(int b, int h, int qb32, int layer, const bf16* QKV, const float* BT, bf16* ATT, LAS char* wl, LAS float* btl, LAS float* wsf, int lane) {
    const int r32 = lane & 31, hi = lane >> 5, kvh = h >> 2;
    const long rowbase = (long)b * SEQ; const int qs = qb32 * 32, qabs = qs + r32;
    const bf16* Qw = QKV + (rowbase + qs) * NQKV + 1536 + h * 64;
    const bf16* ksrc = QKV + rowbase * NQKV + 2048 + kvh * 64 + (long)r32 * NQKV + hi * 8;
    const bf16* vsrc = QKV + rowbase * NQKV + 2176 + kvh * 64 + (long)(lane >> 2) * NQKV + (lane & 3) * 8;
    btl[lane] = BT[h * 128 + lane]; btl[64 + lane] = BT[h * 128 + 64 + lane];
    const float sink = BT[1024 + layer * 8 + h];
    bf16x8 qr[4];
#pragma unroll
    for (int d0 = 0; d0 < 4; ++d0) qr[d0] = *(const bf16x8*)(Qw + (long)r32 * NQKV + d0 * 16 + hi * 8);
    const int jlo = (qs - 127) >> 6;
    const int vofs = (int)(uintptr_t)wl + vlane_ofs(lane, hi);
    asm volatile("s_waitcnt lgkmcnt(0)" ::: "memory");
    bf16x8 kf[8];
    float m = -INFINITY;
#pragma unroll 1
    for (int ii = 0; ii < 3; ++ii) { const int jt = jlo + ii; if (jt < 0) continue;
        load_k(kf, ksrc, jt);
        f32x16 p0, p1; qkt_r(p0, p1, kf, qr);
        const int db = qabs - (64 * jt + 4 * hi);
#pragma unroll
        for (int r = 0; r < 16; ++r) { const int d0_ = db - ((r & 3) + 8 * (r >> 2)), d1_ = d0_ - 32;
            const float s0 = p0[r] + btl[d0_ & 127], s1 = p1[r] + btl[d1_ & 127];
            if ((unsigned)d0_ < 128u) m = __builtin_fmaxf(m, s0);
            if ((unsigned)d1_ < 128u) m = __builtin_fmaxf(m, s1); } }
    m = __builtin_fmaxf(m, other_half(m, hi)); m = __builtin_fmaxf(m, sink);
    f32x16 o[2]; o[0] = f32x16{}; o[1] = f32x16{};
    float l = 0.f;
#pragma unroll 1
    for (int ii = 0; ii < 3; ++ii) { const int jt = jlo + ii; if (jt < 0) continue;
        u32x4 vr[8];
        load_k(kf, ksrc, jt); load_v(vr, vsrc, jt);
        f32x16 p0, p1; qkt_r(p0, p1, kf, qr);
        const int db = qabs - (64 * jt + 4 * hi);
#pragma unroll
        for (int r = 0; r < 16; ++r) { const int d0_ = db - ((r & 3) + 8 * (r >> 2)), d1_ = d0_ - 32;
            const float e0 = __builtin_amdgcn_exp2f(p0[r] + btl[d0_ & 127] - m), e1 = __builtin_amdgcn_exp2f(p1[r] + btl[d1_ & 127] - m);
            p0[r] = (unsigned)d0_ < 128u ? e0 : 0.f; p1[r] = (unsigned)d1_ < 128u ? e1 : 0.f; l += p0[r] + p1[r]; }
        u32x4 w0, w1, w2, w3; pack_p(p0, p1, w0, w1, w2, w3);
        store_v(vr, wl + (ii & 1) * 8192, lane);
        asm volatile("s_waitcnt lgkmcnt(0)" ::: "memory");
        pv(o, vofs + (ii & 1) * 8192, __builtin_bit_cast(bf16x8, w0), __builtin_bit_cast(bf16x8, w1), __builtin_bit_cast(bf16x8, w2), __builtin_bit_cast(bf16x8, w3)); }
    l += other_half(l, hi); l += __builtin_amdgcn_exp2f(sink - m);
    if (hi == 0) wsf[r32] = 1.0f / l;
    asm volatile("s_waitcnt lgkmcnt(0)" ::: "memory");
    float rli[16];
#pragma unroll
    for (int r = 0; r < 16; ++r) rli[r] = wsf[crow(r, hi)];
    store_o(o, rli, (LAS bf16*)wl, ATT + (rowbase + qs) * D + 512 + h * 64, D, lane, r32, hi);
    asm volatile("s_waitcnt lgkmcnt(0)" ::: "memory");
}
#undef SBAR
#undef MFMA32
}


DI void conv_w(const float* W, const float* g, bf16* WT, int K, int N, int ldk, int koff, bool perm_gate, LAS float* scr, int gw, int NGW, int lane) {
    const int nblk = N / 32, nitems = (K / 64) * nblk;
    for (int item = gw; item < nitems; item += NGW) {
        const int kb = item / nblk, nb = item % nblk, k0 = 64 * kb, n0 = 32 * nb;
        int nd = n0;
        if (perm_gate && n0 >= NQKV) { const int c = n0 - NQKV; nd = c < 1024 ? NQKV + 256 * (c >> 7) + (c & 127) : NQKV + 256 * ((c - 1024) >> 7) + 128 + ((c - 1024) & 127); }
#pragma unroll 8
        for (int i = 0; i < 32; ++i) { const int kk = 2 * i + (lane >> 5); const float gs = g ? g[k0 + kk] : 1.0f; scr[kk * 33 + (lane & 31)] = W[(size_t)(k0 + kk) * N + n0 + (lane & 31)] * gs; }
        asm volatile("s_waitcnt lgkmcnt(0)" ::: "memory");
        const int c = lane & 7;
#pragma unroll
        for (int j = 0; j < 4; ++j) { const int n = (lane >> 3) + 8 * j; const LAS float* s = scr + (8 * c) * 33 + n;
            u32x4 o; o.x = pk2(s[0 * 33], s[1 * 33]); o.y = pk2(s[2 * 33], s[3 * 33]); o.z = pk2(s[4 * 33], s[5 * 33]); o.w = pk2(s[6 * 33], s[7 * 33]);
            *(u32x4*)(WT + (size_t)(nd + n) * ldk + koff + k0 + 8 * c) = o; }
        asm volatile("s_waitcnt lgkmcnt(0)" ::: "memory");
    }
}
DI void rownorm_rows(const float* x, bf16* XB, float* SS, int gw, int NGW, int lane) {
    for (int row = gw; row < M; row += NGW) {
        const f32x4* xr = (const f32x4*)(x + (size_t)row * D) + lane; u32x2* o = (u32x2*)(XB + (size_t)row * D) + lane;
        float s = 0.f;
#pragma unroll
        for (int j = 0; j < 4; ++j) { const f32x4 v = xr[64 * j]; s += (v[0] * v[0] + v[1] * v[1]) + (v[2] * v[2] + v[3] * v[3]); u32x2 w; w.x = cvtpk(v[0], v[1]); w.y = cvtpk(v[2], v[3]); o[64 * j] = w; }
        s = wave_sum(s);
        if (lane == 0) *(f32x4*)(SS + (size_t)row * 4) = (f32x4){s, 0.f, 0.f, 0.f};
    }
}
DI void final_rows(const bf16* xb, float* out, const float* SS, const float* gf, int gw, int NGW, int lane, bool dry) {
    for (int row = gw; row < M; row += NGW) {
        const u32x4* xr = (const u32x4*)(xb + (size_t)row * D) + lane; f32x4* orow = (f32x4*)(out + (size_t)row * D) + 2 * lane; const f32x4* g4 = (const f32x4*)gf + 2 * lane;
        const float r = rs_from(*(const f32x4*)(SS + (size_t)row * 4));
#pragma unroll
        for (int j = 0; j < 2; ++j) { f32x4 a, b; unpack8(xr[64 * j], a, b); a = (a * r) * g4[128 * j]; b = (b * r) * g4[128 * j + 1];
            if (!dry) { orow[128 * j] = a; orow[128 * j + 1] = b; } else asm volatile("" :: "v"(a), "v"(b)); }
    }
}
DI int t5_bucket(int d) {
    if (d < 16) return d;
    const int large = 16 + (int)(logf((float)d / 16.0f) / 2.0794415416798357f * 16.0f);
    return large < 31 ? large : 31;
}

#ifndef PROBE_TS
#define PROBE_TS -1
#endif
#ifndef MK_N_LAUNCHES
#define MK_N_LAUNCHES 1
#endif
constexpr int NPH = 16;
struct Args { const float* in[16]; float* out; unsigned char* ws; int ph_lo, ph_hi; };
static_assert(sizeof(Args) == 16 * 8 + 8 + 8 + 8, "Args has no padding");

typedef const __attribute__((address_space(4))) Args* KArgs;
DI KArgs kargs() { KArgs p = (KArgs)__builtin_amdgcn_kernarg_segment_ptr(); asm volatile("" : "+s"(p)); return p; }
struct Ctx { int tid, lane, wave, G, bx, vcu, gw, NGW; };
DI Ctx ctx(int wv) { Ctx c; int z = 0; asm volatile("" : "+v"(z)); const int ln = __builtin_amdgcn_mbcnt_hi(~0u, __builtin_amdgcn_mbcnt_lo(~0u, z)); int t = wv * 64 + ln; asm volatile("" : "+v"(t));
    int b = blockIdx.x; asm volatile("" : "+s"(b)); c.tid = t; c.lane = ln; c.wave = wv;
    c.G = gridDim.x; c.bx = b; c.vcu = (c.G % 8 == 0) ? (b % 8) * (c.G / 8) + b / 8 : b; c.gw = c.vcu * NWAVES + c.wave; c.NGW = c.G * NWAVES; return c; }
#define WSP(T, off) ((T*)(A->ws + (off)))
__global__ void __launch_bounds__(NWAVES * 64, 2) mk_fwd(Args args_unused) {
    extern __shared__ __attribute__((aligned(16))) unsigned char lds_raw[];
    LAS unsigned char* lds = (LAS unsigned char*)lds_raw;
    volatile LAS unsigned* MISC = (volatile LAS unsigned*)(lds + MISC_OFF);
    const int wv = __builtin_amdgcn_readfirstlane(threadIdx.x >> 6);
    for (int u = threadIdx.x; u < (LDS_BYTES - RING_BYTES) / 4; u += NWAVES * 64) ((LAS unsigned*)(lds + RING_BYTES))[u] = 0u;
    __syncthreads();
    int lo, hi;
    if (PROBE_TS >= 0 && blockIdx.x == 0 && threadIdx.x == 0) { KArgs A = kargs(); WSP(unsigned long long, WS_CTL + 32768)[31] = __builtin_amdgcn_s_memrealtime(); }
    XcdBarrier bar;
    { KArgs A = kargs(); lo = A->ph_lo; hi = A->ph_hi; bar.bar = WSP(unsigned, WS_CTL) + CW_BAR; bar.x = 0; bar.st = nullptr;
      if (MK_N_LAUNCHES == 1) bar = xcd_barrier_post(WSP(unsigned, WS_CTL) + CW_BAR, MISC + 8); }
#define IN(k) (lo <= (k) && (k) < hi)
#define STAMP(k) do { if (PROBE_TS >= 0 && blockIdx.x == 0) { const Ctx cs_ = ctx(wv); if (cs_.tid == 0) { KArgs A = kargs(); WSP(unsigned long long, WS_CTL + 32768)[(k)] = __builtin_amdgcn_s_memrealtime(); } } } while (0)
#ifndef PROBE_REP
#define PROBE_REP 0
#endif
#define REP_BEGIN(j) for (int rep_ = 0; rep_ <= ((PROBE_REP >> (j)) & 1); ++rep_) {
#define REP_END(j) if (rep_ < ((PROBE_REP >> (j)) & 1)) { XcdBarrier b_ = bar; asm volatile("" : "+s"(b_.bar)); const Ctx cb_ = ctx(wv); xcd_barrier(b_, cb_.tid == 0); } }
#define SEAM(k) do { if (IN(k) && IN((k) + 1)) { XcdBarrier b_ = bar; asm volatile("" : "+s"(b_.bar)); const Ctx cb_ = ctx(wv); xcd_barrier(b_, cb_.tid == 0); } STAMP(k); } while (0)
#define CONV(W, g, WT, K, N, ldk, koff, perm) conv_w((W), (g), (WT), (K), (N), (ldk), (koff), (perm), (LAS float*)(lds + c.wave * 16384), c.gw, c.NGW, c.lane)

    REP_BEGIN(7)
    if (IN(0)) {
        KArgs A = kargs(); const Ctx c = ctx(wv);
        float* BT = WSP(float, WS_BT);
        if (c.bx == 0) { const float* rel_bias = A->in[15]; const float* sinks = A->in[14];
            for (int i = c.tid; i < 8 * 128; i += NWAVES * 64) { const int h = i >> 7, d = i & 127; BT[i] = rel_bias[t5_bucket(d) * 8 + h] * LOG2E; }
            if (c.tid < 16) BT[1024 + c.tid] = sinks[c.tid] * LOG2E; }
        CONV(A->in[2], A->in[10], WSP(bf16, WS_WIN), D, NIN, D, 0, true);
        CONV(A->in[3], nullptr, WSP(bf16, WS_WUP), 512, D, D, 0, false); CONV(A->in[4], nullptr, WSP(bf16, WS_WUP), 512, D, D, 512, false);
        CONV(A->in[5], nullptr, WSP(bf16, WS_WO), D, D, D, 0, false);
        CONV(A->in[6], A->in[11], WSP(bf16, WS_WFF1), D, FF, D, 0, false); CONV(A->in[7], nullptr, WSP(bf16, WS_WFF2), FF, D, FF, 0, false);
        CONV(A->in[8], nullptr, WSP(bf16, WS_WPE), PLE, D, PLE, 0, false); CONV(A->in[9], A->in[12], WSP(bf16, WS_WPG), D, D, D, 0, false);
        { const float* p_in = A->in[1]; bf16* PB = WSP(bf16, WS_PB);
          for (size_t i = (size_t)c.vcu * (NWAVES * 64) + c.tid; i < (size_t)DEPTH * M * PLE / 4; i += (size_t)c.G * NWAVES * 64) {
            const f32x4 v = ((const f32x4*)p_in)[i]; u32x2 o; o.x = cvtpk(v[0], v[1]); o.y = cvtpk(v[2], v[3]); ((u32x2*)PB)[i] = o; } }
        rownorm_rows(A->in[0], WSP(bf16, WS_XB), WSP(float, WS_SS), c.gw, c.NGW, c.lane);
        __syncthreads();
    }
    REP_END(7)
    SEAM(0);
#pragma unroll 1
    for (int l = 0; l < DEPTH; ++l) {
        const int pb = 1 + 7 * l;
#define SSA WSP(float, WS_SS + (l == 0 ? 0 : (size_t)M * 16))
#define SSB WSP(float, WS_SS + (l == 0 ? (size_t)M * 16 : 0))
        REP_BEGIN(0)
        if (IN(pb)) {
            KArgs A = kargs(); const Ctx c = ctx(wv);
            if (l == 1) { CONV(A->in[9] + (size_t)D * D, A->in[12] + D, WSP(bf16, WS_WPG), D, D, D, 0, false); __syncthreads(); }
            pg8::Gemm g{WSP(bf16, WS_XB), WSP(bf16, WS_WIN), M, NIN, D}; pg8::StaticOrder S; S.init(M, NIN, c.G, c.bx);
            EpiIn E{SSA, WSP(bf16, WS_QKV), WSP(bf16, WS_GATE)};
            pg8::gemm_phase<EpiIn, pg8::StaticOrder, true, true>(lds, g, S, E, c.tid);
        }
        REP_END(0)
        SEAM(pb);
        REP_BEGIN(1)
        if (IN(pb + 1)) {
            KArgs A = kargs(); const Ctx c = ctx(wv);
            if (l == 0) { CONV(A->in[2] + (size_t)D * NIN, A->in[10] + D, WSP(bf16, WS_WIN), D, NIN, D, 0, true); __syncthreads(); }
            __syncthreads();
            { LAS char* wl = (LAS char*)lds + c.wave * 16384;
              LAS float* btl = (LAS float*)(lds + RING_BYTES + 1024) + c.wave * 192; LAS float* wsf = btl + 128;
              for (int u = c.gw; u < BATCH * 8 * (SEQ / 32); u += c.NGW) { const int bh = u >> 7, qb = u & 127; att::sbw_unit<true>(bh >> 3, bh & 7, qb, WSP(bf16, WS_QKV), WSP(bf16, WS_ATT), wl, c.lane); }
              for (int u = c.gw; u < BATCH * 8 * (SEQ / 32); u += c.NGW) { const int bh = u >> 7, qb = u & 127; att::swaw_unit(bh >> 3, bh & 7, qb, l, WSP(bf16, WS_QKV), WSP(float, WS_BT), WSP(bf16, WS_ATT), wl, btl, wsf, c.lane); } }
        }
        REP_END(1)
        SEAM(pb + 1);
        REP_BEGIN(2)
        if (IN(pb + 2)) {
            KArgs A = kargs(); const Ctx c = ctx(wv);
            pg8::Gemm g{WSP(bf16, WS_ATT), WSP(bf16, WS_WUP), M, D, D}; pg8::StaticOrder S; S.init(M, D, c.G, c.bx);
            EpiUp E{WSP(bf16, WS_GATE), WSP(bf16, WS_MRG)};
            pg8::gemm_phase<EpiUp, pg8::StaticOrder, true, true>(lds, g, S, E, c.tid);
        }
        REP_END(2)
        SEAM(pb + 2);
        for (int rep_ = 0; rep_ <= (l == 0 ? ((PROBE_REP >> 3) & 1) : 0); ++rep_) {
        if (IN(pb + 3)) {
            KArgs A = kargs(); const Ctx c = ctx(wv);
            if (l == 0) { CONV(A->in[3] + (size_t)512 * D, nullptr, WSP(bf16, WS_WUP), 512, D, D, 0, false); CONV(A->in[4] + (size_t)512 * D, nullptr, WSP(bf16, WS_WUP), 512, D, D, 512, false); __syncthreads(); }
            if (c.G == 256) {
                pg8::Gemm g{WSP(bf16, WS_MRG), WSP(bf16, WS_WO), M, D, D}; pg8::StaticOrder S; S.init(M, D, c.G, c.bx);
                if (l == 0) { EpiRes<false, true> E{A->in[0], nullptr, WSP(bf16, WS_XB), SSB, nullptr, nullptr, false, bar};
                    pg8::gemm_phase<EpiRes<false, true>, pg8::StaticOrder, false, true>(lds, g, S, E, c.tid); }
                else { EpiRes<false, false> E{nullptr, WSP(bf16, WS_XB), WSP(bf16, WS_XB), SSB, nullptr, nullptr, false, bar};
                    pg8::gemm_phase<EpiRes<false, false>, pg8::StaticOrder, false, true>(lds, g, S, E, c.tid); }
            }
        }
        if (rep_ < (l == 0 ? ((PROBE_REP >> 3) & 1) : 0)) { XcdBarrier b_ = bar; asm volatile("" : "+s"(b_.bar)); const Ctx cb_ = ctx(wv); xcd_barrier(b_, cb_.tid == 0); } }
        SEAM(pb + 3);
        REP_BEGIN(4)
        if (IN(pb + 4)) {
            KArgs A = kargs(); const Ctx c = ctx(wv);
            if (l == 0) { CONV(A->in[5] + (size_t)D * D, nullptr, WSP(bf16, WS_WO), D, D, D, 0, false); __syncthreads(); }
            { pg8::Gemm g{WSP(bf16, WS_XB), WSP(bf16, WS_WFF1), M, FF, D}; pg8::StaticOrder S; S.init(M, FF, c.G, c.bx);
              EpiFf1 E{SSB, WSP(bf16, WS_U)};
              pg8::gemm_phase<EpiFf1, pg8::StaticOrder, true, true>(lds, g, S, E, c.tid); }
        }
        if (IN(pb + 4)) {
            KArgs A = kargs(); const Ctx c = ctx(wv);
            { pg8::Gemm g{WSP(bf16, WS_PB) + (size_t)l * M * PLE, WSP(bf16, WS_WPE), M, D, PLE}; pg8::StaticOrder S; S.init(M, D, c.G, c.bx);
              EpiPe E{WSP(bf16, WS_PE)};
              pg8::gemm_phase<EpiPe, pg8::StaticOrder, true, true>(lds, g, S, E, c.tid); }
        }
        REP_END(4)
        SEAM(pb + 4);
        if (IN(pb + 5)) {
            KArgs A = kargs(); const Ctx c = ctx(wv);
            if (l == 0) { CONV(A->in[6] + (size_t)D * FF, A->in[11] + D, WSP(bf16, WS_WFF1), D, FF, D, 0, false); CONV(A->in[8] + (size_t)PLE * D, nullptr, WSP(bf16, WS_WPE), PLE, D, PLE, 0, false); __syncthreads(); }
            if (c.G == 256) {
                pg8::Gemm g{WSP(bf16, WS_U), WSP(bf16, WS_WFF2), M, D, FF}; pg8::StaticOrder S; S.init(M, D, c.G, c.bx);
                for (int rep_ = ((PROBE_REP >> 5) & 1); rep_ >= 0; --rep_) { EpiRes<false, false> E{nullptr, WSP(bf16, WS_XB), WSP(bf16, WS_XB), SSA, nullptr, nullptr, rep_ != 0, bar};
                pg8::gemm_phase<EpiRes<false, false>, pg8::StaticOrder, false, true>(lds, g, S, E, c.tid); }
            }
        }
        SEAM(pb + 5);
        if (IN(pb + 6)) {
            KArgs A = kargs(); const Ctx c = ctx(wv);
            if (l == 0) { CONV(A->in[7] + (size_t)FF * D, nullptr, WSP(bf16, WS_WFF2), FF, D, FF, 0, false); __syncthreads(); }
            if (c.G == 256) {
                pg8::Gemm g{WSP(bf16, WS_XB), WSP(bf16, WS_WPG), M, D, D}; pg8::StaticOrder S; S.init(M, D, c.G, c.bx);
                for (int rep_ = ((PROBE_REP >> 6) & 1); rep_ >= 0; --rep_) { XcdBarrier b_ = bar; asm volatile("" : "+s"(b_.bar)); EpiRes<true, false> E{nullptr, WSP(bf16, WS_XB), WSP(bf16, WS_XB), SSB, WSP(bf16, WS_PE), SSA, rep_ != 0, b_};
                pg8::gemm_phase<EpiRes<true, false>, pg8::StaticOrder, false, true>(lds, g, S, E, c.tid); }
            }
        }
        SEAM(pb + 6);
    }
    if (IN(NPH - 1)) { KArgs A = kargs(); const Ctx c = ctx(wv); for (int rep_ = ((PROBE_REP >> 8) & 1); rep_ >= 0; --rep_) final_rows(WSP(bf16, WS_XB), A->out, WSP(float, WS_SS), A->in[13], c.gw, c.NGW, c.lane, rep_ != 0); }
    if (PROBE_TS >= 0) {
        __syncthreads(); KArgs A = kargs(); const Ctx c = ctx(wv); const unsigned long long* ts = WSP(unsigned long long, WS_CTL + 32768);
        const unsigned long long t1 = __hip_atomic_load(ts + PROBE_TS, __ATOMIC_RELAXED, __HIP_MEMORY_SCOPE_AGENT), t0 = __hip_atomic_load(ts + (PROBE_TS == 0 ? 31 : PROBE_TS - 1), __ATOMIC_RELAXED, __HIP_MEMORY_SCOPE_AGENT);
        const float V = (float)(t1 - t0) * (0.01f / 30.0f);
        for (size_t i = (size_t)c.vcu * (NWAVES * 64) + c.tid; i < (size_t)M * D / 4; i += (size_t)c.G * NWAVES * 64) ((f32x4*)A->out)[i] = (f32x4){V, V, V, V};
    }
#undef IN
#undef SEAM
#undef CONV
}

extern "C" void kernel_launch(void* const* d_in, const int* in_sizes, int n_in, void* d_out, int out_size, void* d_ws, size_t ws_size, hipStream_t stream) {
    static int grid = 0;
    if (grid == 0) {
        if (n_in != 16 || in_sizes[0] != M * D || out_size != M * D || ws_size < WS_END) { fprintf(stderr, "kernel_launch: unexpected shapes (n_in %d, in0 %d, out %d, ws %zu); nothing launched\n", n_in, n_in > 0 ? in_sizes[0] : -1, out_size, ws_size); grid = -1; return; }
        int dev = 0, cus = 0, per_cu = 0;
        if (hipGetDevice(&dev) != hipSuccess || hipDeviceGetAttribute(&cus, hipDeviceAttributeMultiprocessorCount, dev) != hipSuccess) { fprintf(stderr, "kernel_launch: device query failed\n"); grid = -1; return; }
        if (hipFuncSetAttribute((const void*)mk_fwd, hipFuncAttributeMaxDynamicSharedMemorySize, LDS_BYTES) != hipSuccess) { fprintf(stderr, "kernel_launch: hipFuncSetAttribute failed\n"); grid = -1; return; }
        if (hipOccupancyMaxActiveBlocksPerMultiprocessor(&per_cu, (const void*)mk_fwd, NWAVES * 64, LDS_BYTES) != hipSuccess || per_cu < 1) fprintf(stderr, "kernel_launch: note: occupancy query reports %d workgroups per CU\n", per_cu);
        (void)hipGetLastError();
        grid = cus;
        if (grid != 256) fprintf(stderr, "kernel_launch: %d CUs; the single-unit GEMM phases need exactly 256 workgroups\n", grid);
    }
    if (grid < 0) return;
    if (hipMemsetAsync((char*)d_ws + WS_CTL, 0, CTL_ZERO_BYTES, stream) != hipSuccess) { fprintf(stderr, "kernel_launch: memset failed\n"); return; }
    Args a{};
    for (int i = 0; i < 16; ++i) a.in[i] = (const float*)d_in[i];
    a.out = (float*)d_out; a.ws = (unsigned char*)d_ws;
    if (MK_N_LAUNCHES == 1) { a.ph_lo = 0; a.ph_hi = NPH; hipLaunchKernelGGL(mk_fwd, dim3(grid), dim3(NWAVES * 64), LDS_BYTES, stream, a); }
    else for (int li = 0; li < NPH; ++li) { a.ph_lo = li; a.ph_hi = li + 1; hipLaunchKernelGGL(mk_fwd, dim3(grid), dim3(NWAVES * 64), LDS_BYTES, stream, a); }
    const hipError_t le = hipPeekAtLastError();
    if (le != hipSuccess) fprintf(stderr, "kernel_launch: launch failed: %s\n", hipGetErrorName(le));
}
```

```cpp
#include <hip/hip_runtime.h>
#include <cstdio>
#include <cstdint>
#define LAS __attribute__((address_space(3)))

namespace pg8 {
#define PG8_LAS __attribute__((address_space(3)))
typedef unsigned short bf16_t;
typedef short bf16x8 __attribute__((ext_vector_type(8)));
typedef float f32x4 __attribute__((ext_vector_type(4)));
typedef unsigned u32x4 __attribute__((ext_vector_type(4)));
constexpr int BM = 256, BK = 64, HALF = 128, HTB = HALF * BK * 2  , STAGE_BYTES = 8 * HTB, NXCD = 8, WGM = 8;

__host__ __device__ __forceinline__ int lds_byte(int r, int c) { const int st = (r >> 4) * 2 + (c >> 5), rr = r & 15, cc = c & 31, ob = rr * 64 + cc * 2; return st * 1024 + (ob ^ (((ob >> 9) & 1) << 5)); }
__host__ __device__ __forceinline__ void stage_rc(int b, int& R, int& C) { const int st = b / 1024, sb = b % 1024, swz = sb ^ (((sb >> 9) & 1) << 5); R = (st >> 1) * 16 + swz / 64; C = (st & 1) * 32 + (swz % 64) / 2; }
__host__ __device__ __forceinline__ int perm32(int rho) { const int n = rho >> 4, i = rho & 15; return 8 * (i >> 2) + 4 * n + (i & 3); }

struct Unit { int pm, pn; };
struct Gemm { const bf16_t* A; const bf16_t* Bt; int M, N, K; };

struct StaticOrder {
    int nM, nN, nwg, G, c;
    __host__ __device__ void init(int M, int N, int G_, int c_) { nM = M / BM; nN = N / BM; nwg = nM * nN; G = G_; c = c_; }
    __host__ __device__ bool next(int i, Unit& u) const {
        const long L = (long)i * G + c; if (L >= nwg) return false;
        int wgid = (int)L; { const int q = nwg / NXCD, r = nwg % NXCD, xcd = wgid % NXCD, off = wgid / NXCD; wgid = (xcd < r ? xcd * (q + 1) : r * (q + 1) + (xcd - r) * q) + off; }
        const int nig = WGM * nN, gid = wgid / nig, fm = gid * WGM, gsz = (nM - fm) < WGM ? (nM - fm) : WGM;
        u.pm = fm + ((wgid % nig) % gsz); u.pn = (wgid % nig) / gsz; return true;
    }
    __device__ __forceinline__ void a_ready(const Unit&) const {}
    __device__ __forceinline__ void done(const Unit&) const {}
};

__device__ __forceinline__ unsigned cvt_pk_bf16(float lo, float hi) { unsigned r; asm volatile("v_cvt_pk_bf16_f32 %0, %1, %2" : "=v"(r) : "v"(lo), "v"(hi)); return r; }
template <class Epi, class Sched, bool ALIGN_EPI = false, bool SP2 = false>
__device__ __forceinline__ void gemm_phase(PG8_LAS unsigned char* lds, const Gemm g, const Sched& S, const Epi& E, const int tid_in) {
    int tid_ = tid_in; asm volatile("" : "+v"(tid_));
    const int tid = tid_, wid = __builtin_amdgcn_readfirstlane(tid >> 6), lane = tid & 63, wr = wid >> 2, wc = wid & 3, fr = lane & 15, fq = lane >> 4;
    int K_ = g.K; asm volatile("" : "+s"(K_));
    const int K = K_, nt = K / BK;
    unsigned voffA[2], voffB[2];
#pragma unroll
    for (int i = 0; i < 2; ++i) { int R, C; stage_rc(tid * 16 + i * 8192, R, C); const int Rb = Epi::PERM ? ((R & ~31) + perm32(R & 31)) : R;
        voffA[i] = (unsigned)(R * K + C) * 2u; voffB[i] = (unsigned)(Rb * K + C) * 2u; }
    const size_t kstep = (size_t)(BK * 2);
    const size_t hstep = (size_t)HALF * K * 2;
    const size_t tstep = 2 * hstep;
    const unsigned ldsw = (unsigned)wid * 1024u;
    const int aoff = lds_byte(wr * 64 + fr, fq * 8), boff = lds_byte(wc * 32 + fr, fq * 8);
#define PG8_SA(b, h) (((b) * 2 + (h)) * HTB)
#define PG8_SB(b, h) ((4 + (b) * 2 + (h)) * HTB)
#define PG8_STAGE(bufoff, gbase, voff) do { _Pragma("unroll") for (int _i = 0; _i < 2; ++_i) \
        __builtin_amdgcn_global_load_lds((const unsigned*)((const char*)(gbase) + (voff)[_i]), (PG8_LAS unsigned*)(lds + (bufoff) + ldsw + _i * 8192), 16, 0, 0); } while (0)
#define PG8_LDA(dst, b, h) do { _Pragma("unroll") for (int m = 0; m < 4; ++m) _Pragma("unroll") for (int k = 0; k < 2; ++k) dst[m][k] = *(const PG8_LAS bf16x8*)(lds + PG8_SA(b, h) + aoff + m * 2048 + k * 1024); } while (0)
#define PG8_LDB(dst, b, h) do { _Pragma("unroll") for (int n = 0; n < 2; ++n) _Pragma("unroll") for (int k = 0; k < 2; ++k) dst[n][k] = *(const PG8_LAS bf16x8*)(lds + PG8_SB(b, h) + boff + n * 2048 + k * 1024); } while (0)
#define PG8_MMA(ai, bj, At, Bt) do { __builtin_amdgcn_s_setprio(1); _Pragma("unroll") for (int m = 0; m < 4; ++m) _Pragma("unroll") for (int n = 0; n < 2; ++n) _Pragma("unroll") for (int k = 0; k < 2; ++k) \
        acc[ai][bj][m][n] = __builtin_amdgcn_mfma_f32_16x16x32_bf16(Bt[n][k], At[m][k], acc[ai][bj][m][n], 0, 0, 0); __builtin_amdgcn_s_setprio(0); } while (0)
#define PG8_WAIT_V(n) asm volatile("s_waitcnt vmcnt(" #n ")" ::: "memory")
#define PG8_WAIT_L(n) asm volatile("s_waitcnt lgkmcnt(" #n ")" ::: "memory")
#define PG8_BAR __builtin_amdgcn_s_barrier()
#define PG8_SCHED __builtin_amdgcn_sched_barrier(0)
    Unit cur, nxt; int ui = 0;
    if (!S.next(0, cur)) return;
    f32x4 acc[2][2][4][2];
#pragma unroll
    for (int a = 0; a < 2; ++a)
#pragma unroll
        for (int b = 0; b < 2; ++b)
#pragma unroll
            for (int m = 0; m < 4; ++m)
#pragma unroll
                for (int n = 0; n < 2; ++n) acc[a][b][m][n] = (f32x4){0.f, 0.f, 0.f, 0.f};
    bf16x8 At[4][2], B0[2][2], B1[2][2];
    const char* cA = (const char*)g.A + (size_t)cur.pm * tstep; const char* cB = (const char*)g.Bt + (size_t)cur.pn * tstep;
    S.a_ready(cur);
    if constexpr (SP2) {
        PG8_STAGE(PG8_SB(0, 0), cB, voffB); PG8_STAGE(PG8_SB(0, 1), cB + hstep, voffB); PG8_STAGE(PG8_SA(0, 0), cA, voffA); PG8_STAGE(PG8_SA(0, 1), cA + hstep, voffA);
        if (wr == 1) PG8_BAR;
        PG8_WAIT_V(2); PG8_BAR;
        PG8_STAGE(PG8_SB(1, 0), cB + kstep, voffB); PG8_STAGE(PG8_SA(1, 0), cA + kstep, voffA); PG8_STAGE(PG8_SB(1, 1), cB + hstep + kstep, voffB);
        PG8_WAIT_V(6); PG8_BAR;
    } else {
        PG8_STAGE(PG8_SB(0, 0), cB, voffB); PG8_STAGE(PG8_SA(0, 0), cA, voffA); PG8_STAGE(PG8_SB(0, 1), cB + hstep, voffB); PG8_STAGE(PG8_SA(0, 1), cA + hstep, voffA);
        if (wr == 1) PG8_BAR;
        PG8_WAIT_V(4); PG8_BAR;
        PG8_STAGE(PG8_SB(1, 0), cB + kstep, voffB); PG8_STAGE(PG8_SA(1, 0), cA + kstep, voffA); PG8_STAGE(PG8_SB(1, 1), cB + hstep + kstep, voffB);
        PG8_WAIT_V(6); PG8_BAR;
    }
    for (;;) {
        const bool has_next = S.next(ui + 1, nxt);
        const char* nA = has_next ? (const char*)g.A + (size_t)nxt.pm * tstep : cA; const char* nB = has_next ? (const char*)g.Bt + (size_t)nxt.pn * tstep : cB;
        for (int t = 0; t < nt; t += 2) {
            const bool last = (t == nt - 2);
            if constexpr (Epi::MIDSCALE) { if (t == (nt >> 1)) E.mid(acc, cur, wr, wc, fr, fq); }
            const char* a1 = cA + (size_t)(t + 1) * kstep;
            const char* a2 = last ? nA : cA + (size_t)(t + 2) * kstep; const char* b2 = last ? nB : cB + (size_t)(t + 2) * kstep;
            const char* a3 = a2 + kstep; const char* b3 = b2 + kstep;
            if (last && has_next) S.a_ready(nxt);
            if constexpr (SP2) {
            PG8_LDB(B0, 0, 0); PG8_LDB(B1, 0, 1); PG8_SCHED; PG8_LDA(At, 0, 0); PG8_STAGE(PG8_SA(1, 1), a1 + hstep, voffA);
            PG8_WAIT_V(8); PG8_WAIT_L(0); PG8_BAR; PG8_MMA(0, 0, At, B0); PG8_MMA(0, 1, At, B1); PG8_BAR; PG8_SCHED;
            PG8_LDA(At, 0, 1); PG8_STAGE(PG8_SB(0, 0), b2, voffB); PG8_STAGE(PG8_SB(0, 1), b2 + hstep, voffB); PG8_STAGE(PG8_SA(0, 0), a2, voffA);
            PG8_WAIT_V(8); PG8_WAIT_L(0); PG8_BAR; PG8_MMA(1, 0, At, B0); PG8_MMA(1, 1, At, B1); PG8_BAR; PG8_SCHED;
            PG8_LDB(B0, 1, 0); PG8_LDB(B1, 1, 1); PG8_SCHED; PG8_LDA(At, 1, 0); PG8_STAGE(PG8_SA(0, 1), a2 + hstep, voffA);
            PG8_WAIT_V(8); PG8_WAIT_L(0); PG8_BAR; PG8_MMA(0, 0, At, B0); PG8_MMA(0, 1, At, B1); PG8_BAR; PG8_SCHED;
            PG8_LDA(At, 1, 1); PG8_STAGE(PG8_SB(1, 0), b3, voffB); PG8_STAGE(PG8_SB(1, 1), b3 + hstep, voffB); PG8_STAGE(PG8_SA(1, 0), a3, voffA);
            PG8_WAIT_V(8); PG8_WAIT_L(0); PG8_BAR; PG8_MMA(1, 0, At, B0); PG8_MMA(1, 1, At, B1); PG8_BAR; PG8_SCHED;
            } else {
            PG8_LDB(B0, 0, 0); PG8_SCHED; PG8_LDA(At, 0, 0); PG8_STAGE(PG8_SA(1, 1), a1 + hstep, voffA);
            PG8_WAIT_L(8); PG8_BAR; PG8_WAIT_L(0); PG8_MMA(0, 0, At, B0); PG8_BAR; PG8_SCHED;
            PG8_LDB(B1, 0, 1); PG8_STAGE(PG8_SB(0, 0), b2, voffB);
            PG8_BAR; PG8_WAIT_L(0); PG8_MMA(0, 1, At, B1); PG8_BAR;
            PG8_LDA(At, 0, 1); PG8_STAGE(PG8_SA(0, 0), a2, voffA);
            PG8_BAR; PG8_WAIT_L(0); PG8_MMA(1, 0, At, B0); PG8_BAR; PG8_SCHED;
            PG8_STAGE(PG8_SB(0, 1), b2 + hstep, voffB);
            PG8_WAIT_V(6); PG8_BAR; PG8_MMA(1, 1, At, B1); PG8_BAR;
            PG8_LDB(B0, 1, 0); PG8_SCHED; PG8_LDA(At, 1, 0); PG8_STAGE(PG8_SA(0, 1), a2 + hstep, voffA);
            PG8_WAIT_L(8); PG8_BAR; PG8_WAIT_L(0); PG8_MMA(0, 0, At, B0); PG8_BAR; PG8_SCHED;
            PG8_LDB(B1, 1, 1); PG8_STAGE(PG8_SB(1, 0), b3, voffB);
            PG8_BAR; PG8_WAIT_L(0); PG8_MMA(0, 1, At, B1); PG8_BAR;
            PG8_LDA(At, 1, 1); PG8_STAGE(PG8_SA(1, 0), a3, voffA);
            PG8_BAR; PG8_WAIT_L(0); PG8_MMA(1, 0, At, B0); PG8_BAR; PG8_SCHED;
            PG8_STAGE(PG8_SB(1, 1), b3 + hstep, voffB);
            PG8_WAIT_V(6); PG8_BAR; PG8_MMA(1, 1, At, B1); PG8_BAR;
            }
        }
        if constexpr (ALIGN_EPI) { if (wr == 0) PG8_BAR; }
        if constexpr (!Epi::AFTER_DRAIN) { E(acc, cur, wr, wc, fr, fq); S.done(cur); }
        if (!has_next) break;
#pragma unroll
        for (int a = 0; a < 2; ++a)
#pragma unroll
            for (int b = 0; b < 2; ++b)
#pragma unroll
                for (int m = 0; m < 4; ++m)
#pragma unroll
                    for (int n = 0; n < 2; ++n) acc[a][b][m][n] = (f32x4){0.f, 0.f, 0.f, 0.f};
        cur = nxt; cA = nA; cB = nB; ++ui;
        if constexpr (ALIGN_EPI) { if (wr == 1) PG8_BAR; }
    }
    PG8_WAIT_V(0);
    if constexpr (!ALIGN_EPI) { if (wr == 0) PG8_BAR; }
    PG8_BAR;
    if constexpr (Epi::AFTER_DRAIN) { E.fused(acc, cur, wr, wc, fr, fq, lds, wid, lane); S.done(cur); }
#undef PG8_SA
#undef PG8_SB
#undef PG8_STAGE
#undef PG8_LDA
#undef PG8_LDB
#undef PG8_MMA
#undef PG8_WAIT_V
#undef PG8_WAIT_L
#undef PG8_BAR
#undef PG8_SCHED
}
}

#define XB_TMO      128
#define XB_XCNT(j)  (256  + 64 * (j))
#define XB_XSUB(j)  (1280 + 64 * (j))
#define XB_XGEN(j)  (2304 + 64 * (j))
#define XB_TOP      3328
#define XB_TOPGEN   3392
#define XCD_BAR_WORDS 3456
#define XB_SPIN_CAP (1u << 18)

__device__ __forceinline__ unsigned xb_ld(unsigned* p)              { return __hip_atomic_load(p, __ATOMIC_RELAXED, __HIP_MEMORY_SCOPE_AGENT); }
__device__ __forceinline__ unsigned xb_add(unsigned* p, unsigned v) { return __hip_atomic_fetch_add(p, v, __ATOMIC_RELAXED, __HIP_MEMORY_SCOPE_AGENT); }
__device__ __forceinline__ unsigned xb_xcc_id() { return (unsigned)__builtin_amdgcn_s_getreg((3 << 11) | 20) & 0xFu; }
#define XB_SPIN(cond, bar) do { unsigned _sp = 0; while (cond) { __builtin_amdgcn_s_sleep(1); \
    if ((++_sp & 255u) == 0u) { if (xb_ld(&(bar)[XB_TMO])) break; if (_sp > XB_SPIN_CAP) { atomicAdd(&(bar)[XB_TMO], 1u); break; } } } } while (0)

struct XcdBarrier {
    unsigned* bar; unsigned x;
    volatile LAS unsigned* st;
};

__device__ __forceinline__ XcdBarrier xcd_barrier_post(unsigned* bar, volatile LAS unsigned* st) {
    XcdBarrier b; b.bar = bar; b.x = xb_xcc_id(); b.st = st;
    if (threadIdx.x == 0) (void)xb_add(&bar[XB_XCNT(b.x)], 1u);
    return b;
}
__device__ __forceinline__ void xcd_barrier_complete(unsigned* bar, unsigned x, unsigned& nloc, unsigned& nx) {
    const unsigned G = gridDim.x * gridDim.y * gridDim.z;
    unsigned sum, cnt, mine, sp = 0u;
    for (;;) {
        sum = 0u; cnt = 0u; mine = 0u;
#pragma unroll
        for (unsigned j = 0; j < 16; ++j) { const unsigned c = xb_ld(&bar[XB_XCNT(j)]); sum += c; cnt += (c > 0u) ? 1u : 0u; mine = (j == x) ? c : mine; }
        if (sum == G) break;
        __builtin_amdgcn_s_sleep(1);
        if ((++sp & 255u) == 0u) { if (xb_ld(&bar[XB_TMO])) break; if (sp > XB_SPIN_CAP) { atomicAdd(&bar[XB_TMO], 1u); break; } }
    }
    nloc = mine > 0u ? mine : 1u; nx = cnt > 0u ? cnt : 1u;
}

__device__ __forceinline__ void xcd_barrier(const XcdBarrier& b, const bool is_t0  ) {
    asm volatile("s_waitcnt vmcnt(0)" ::: "memory");
    __syncthreads();
    if (is_t0) {
        unsigned* bar = b.bar;
        __builtin_amdgcn_s_waitcnt(0);
        unsigned nloc = b.st[0], nx = b.st[1];
        if (nloc == 0u) { xcd_barrier_complete(bar, b.x, nloc, nx); b.st[0] = nloc; b.st[1] = nx; }
        const unsigned old = xb_add(&bar[XB_XSUB(b.x)], 1u);
        const unsigned gen = old / nloc;
        if (old + 1u == (gen + 1u) * nloc) {
            __builtin_amdgcn_fence(__ATOMIC_RELEASE, "agent");
            asm volatile("s_waitcnt vmcnt(0)" ::: "memory");
            const unsigned og = xb_add(&bar[XB_TOP], 1u);
            const unsigned tg = og / nx;
            if (og + 1u == (tg + 1u) * nx) xb_add(&bar[XB_TOPGEN], 1u);
            else XB_SPIN(xb_ld(&bar[XB_TOPGEN]) == tg, bar);
            __builtin_amdgcn_fence(__ATOMIC_ACQUIRE, "agent");
            xb_add(&bar[XB_XGEN(b.x)], 1u);
            asm volatile("s_waitcnt vmcnt(0)" ::: "memory");
        } else {
            XB_SPIN(xb_ld(&bar[XB_XGEN(b.x)]) == gen, bar);
            __builtin_amdgcn_fence(__ATOMIC_ACQUIRE, "agent");
            asm volatile("s_waitcnt vmcnt(0)" ::: "memory");
        }
    }
    __syncthreads();
}


typedef unsigned short bf16;
typedef short bf16x8 __attribute__((ext_vector_type(8)));
typedef float f32x4 __attribute__((ext_vector_type(4)));
typedef unsigned u32x4 __attribute__((ext_vector_type(4)));
typedef unsigned u32x2 __attribute__((ext_vector_type(2)));
#define GAS __attribute__((address_space(1)))
#define DI __device__ __forceinline__

constexpr int BATCH = 4, SEQ = 4096, D = 1024, DEPTH = 2;
constexpr int M = BATCH * SEQ;
constexpr int NIN = 4352, FF = 4096, PLE = 256;
constexpr int NQKV = 2304, NGATE = 2048;
constexpr float EPS = 1e-6f;
constexpr float LOG2E = 1.4426950408889634f;
constexpr float C2 = 0.125f * LOG2E;
constexpr int NWAVES = 8;

constexpr size_t MiB = 1u << 20;
constexpr size_t WS_CTL = 0, CTL_ZERO_BYTES = 64 * 1024;
constexpr size_t WS_WIN = 1 * MiB;
constexpr size_t WS_WUP = WS_WIN + (size_t)NIN * D * 2;
constexpr size_t WS_WO = WS_WUP + 2 * MiB;
constexpr size_t WS_WFF1 = WS_WO + 2 * MiB;
constexpr size_t WS_WFF2 = WS_WFF1 + 8 * MiB;
constexpr size_t WS_WPE = WS_WFF2 + 8 * MiB;
constexpr size_t WS_WPG = WS_WPE + MiB / 2;
constexpr size_t WS_SS = 32 * MiB;
constexpr size_t WS_BT = 33 * MiB;
constexpr size_t WS_PB = 34 * MiB;
constexpr size_t WS_XB = 50 * MiB;
constexpr size_t WS_ATT = 82 * MiB;
constexpr size_t WS_QKV = 114 * MiB;
constexpr size_t WS_GATE = 186 * MiB;
constexpr size_t WS_MRG = WS_QKV;
constexpr size_t WS_U = WS_QKV;
constexpr size_t WS_PE = WS_ATT;
constexpr size_t WS_END = 250 * MiB;
static_assert(WS_WPG + 2 * MiB <= WS_SS && WS_U + (size_t)M * FF * 2 <= WS_END && WS_GATE + (size_t)M * NGATE * 2 <= WS_END, "ws map");
constexpr int CW_BAR = 4096;

constexpr int RING_BYTES = 131072;
constexpr int MISC_OFF = RING_BYTES + 320;
constexpr int LDS_BYTES = 147456;

DI unsigned f2bf(float f) { unsigned u = __builtin_bit_cast(unsigned, f); return (u + 0x7fffu + ((u >> 16) & 1u)) >> 16; }
DI unsigned pk2(float lo, float hi) { return f2bf(lo) | (f2bf(hi) << 16); }
typedef float f32x2_t __attribute__((ext_vector_type(2))); typedef __bf16 bf16x2_t __attribute__((ext_vector_type(2)));
DI unsigned cvtpk(float lo, float hi) { f32x2_t v = {lo, hi}; bf16x2_t b = __builtin_convertvector(v, bf16x2_t); return __builtin_bit_cast(unsigned, b); }
DI u32x4 pack8(f32x4 a, f32x4 b) { u32x4 w; w.x = cvtpk(a[0], a[1]); w.y = cvtpk(a[2], a[3]); w.z = cvtpk(b[0], b[1]); w.w = cvtpk(b[2], b[3]); return w; }
DI void unpack8(u32x4 w, f32x4& a, f32x4& b) {
    a = (f32x4){__builtin_bit_cast(float, w.x << 16), __builtin_bit_cast(float, w.x & 0xffff0000u), __builtin_bit_cast(float, w.y << 16), __builtin_bit_cast(float, w.y & 0xffff0000u)};
    b = (f32x4){__builtin_bit_cast(float, w.z << 16), __builtin_bit_cast(float, w.z & 0xffff0000u), __builtin_bit_cast(float, w.w << 16), __builtin_bit_cast(float, w.w & 0xffff0000u)}; }
template <int X> DI float swz_xor(float v) { return __builtin_bit_cast(float, __builtin_amdgcn_ds_swizzle(__builtin_bit_cast(int, v), (X << 10) | 0x1f)); }
DI float sum_halves(float v) { auto rr = __builtin_amdgcn_permlane32_swap(__float_as_uint(v), __float_as_uint(v), false, false); return __uint_as_float(rr[0]) + __uint_as_float(rr[1]); }
DI float wave_sum(float v) { v += swz_xor<1>(v); v += swz_xor<2>(v); v += swz_xor<4>(v); v += swz_xor<8>(v); v += swz_xor<16>(v); return sum_halves(v); }
DI float rs_from(f32x4 s) { return 1.0f / sqrtf(((s[0] + s[1]) + (s[2] + s[3])) * (1.0f / D) + EPS); }
DI float sigm(float v) { return 1.0f / (1.0f + __expf(-v)); }
#define MEMFENCE() asm volatile("" ::: "memory")

using pg8::Unit;
constexpr int HALF = 128;
DI void load_rs8(const float* SS, int row0, float (&rs)[2][4]) {
    f32x4 s[2][4];
#pragma unroll
    for (int ai = 0; ai < 2; ++ai)
#pragma unroll
        for (int m = 0; m < 4; ++m) s[ai][m] = *(const f32x4*)(SS + (size_t)(row0 + ai * HALF + m * 16) * 4);
#pragma unroll
    for (int ai = 0; ai < 2; ++ai)
#pragma unroll
        for (int m = 0; m < 4; ++m) rs[ai][m] = rs_from(s[ai][m]);
}

struct EpiIn {
    static constexpr bool PERM = true, AFTER_DRAIN = false, MIDSCALE = false;
    const float* SS; bf16* QKV; bf16* GATE;
    DI void operator()(const f32x4 (&acc)[2][2][4][2], const Unit& u, int wr, int wc, int fr, int fq) const {
        const int row0 = u.pm * 256 + wr * 64 + fr;
        float rs[2][4]; load_rs8(SS, row0, rs);
        if (u.pn < 9) {
            const float cs = (u.pn < 2 || u.pn == 6 || u.pn == 7) ? C2 : 1.0f;
            const int col0 = u.pn * 256 + wc * 32 + 8 * fq;
#pragma unroll
            for (int ai = 0; ai < 2; ++ai)
#pragma unroll
                for (int m = 0; m < 4; ++m) { const float sc = rs[ai][m] * cs; bf16* rowp = QKV + (size_t)(row0 + ai * HALF + m * 16) * NQKV + col0;
#pragma unroll
                    for (int bj = 0; bj < 2; ++bj) *(u32x4*)(rowp + bj * HALF) = pack8(acc[ai][bj][m][0] * sc, acc[ai][bj][m][1] * sc); }
        } else {
            const int c0 = (u.pn - 9) * 128 + wc * 32 + 8 * fq;
#pragma unroll
            for (int ai = 0; ai < 2; ++ai)
#pragma unroll
                for (int m = 0; m < 4; ++m) { const float r = rs[ai][m]; bf16* rowp = GATE + (size_t)(row0 + ai * HALF + m * 16) * NGATE + c0;
                    f32x4 ra[2], gb[2];
#pragma unroll
                    for (int n = 0; n < 2; ++n)
#pragma unroll
                        for (int j = 0; j < 4; ++j) { const float ea = fminf(__expf(-acc[ai][0][m][n][j] * r), 1e30f), eb = fminf(__expf(-acc[ai][1][m][n][j] * r), 1e30f);
                            const float g = 1.0f / (1.0f + eb); gb[n][j] = g; ra[n][j] = (1.0f + eb) / (1.0f + ea); }
                    *(u32x4*)rowp = pack8(ra[0], ra[1]); *(u32x4*)(rowp + 1024) = pack8(gb[0], gb[1]); }
        }
    }
};
struct EpiUp {
    static constexpr bool PERM = true, AFTER_DRAIN = false, MIDSCALE = true;
    const bf16* GATE; bf16* MRG;
    DI void mid(f32x4 (&acc)[2][2][4][2], const Unit& u, int wr, int wc, int fr, int fq) const {
        const int row0 = u.pm * 256 + wr * 64 + fr, col0 = u.pn * 256 + wc * 32 + 8 * fq;
#pragma unroll
        for (int ai = 0; ai < 2; ++ai)
#pragma unroll
            for (int m = 0; m < 4; ++m) { const bf16* rowp = GATE + (size_t)(row0 + ai * HALF + m * 16) * NGATE + col0;
#pragma unroll
                for (int bj = 0; bj < 2; ++bj) { f32x4 a, b; unpack8(*(const u32x4*)(rowp + bj * HALF), a, b); acc[ai][bj][m][0] *= a; acc[ai][bj][m][1] *= b; }
                MEMFENCE(); }
    }
    DI void operator()(const f32x4 (&acc)[2][2][4][2], const Unit& u, int wr, int wc, int fr, int fq) const {
        const int row0 = u.pm * 256 + wr * 64 + fr, col0 = u.pn * 256 + wc * 32 + 8 * fq;
#pragma unroll
        for (int ai = 0; ai < 2; ++ai)
#pragma unroll
            for (int m = 0; m < 4; ++m) { const size_t r = (size_t)(row0 + ai * HALF + m * 16);
#pragma unroll
                for (int bj = 0; bj < 2; ++bj) { f32x4 a, b; unpack8(*(const u32x4*)(GATE + r * NGATE + 1024 + col0 + bj * HALF), a, b);
                    *(u32x4*)(MRG + r * D + col0 + bj * HALF) = pack8(acc[ai][bj][m][0] * a, acc[ai][bj][m][1] * b); }
                if (m & 1) MEMFENCE(); }
    }
};
struct EpiFf1 {
    static constexpr bool PERM = true, AFTER_DRAIN = false, MIDSCALE = false;
    const float* SS; bf16* U;
    DI void operator()(const f32x4 (&acc)[2][2][4][2], const Unit& u, int wr, int wc, int fr, int fq) const {
        const int row0 = u.pm * 256 + wr * 64 + fr, col0 = u.pn * 256 + wc * 32 + 8 * fq;
        float rs[2][4]; load_rs8(SS, row0, rs);
#pragma unroll
        for (int ai = 0; ai < 2; ++ai)
#pragma unroll
            for (int m = 0; m < 4; ++m) { const float r = rs[ai][m]; bf16* rowp = U + (size_t)(row0 + ai * HALF + m * 16) * FF + col0;
#pragma unroll
                for (int bj = 0; bj < 2; ++bj) { f32x4 v0 = acc[ai][bj][m][0] * r, v1 = acc[ai][bj][m][1] * r;
#pragma unroll
                    for (int j = 0; j < 4; ++j) { const float a = fmaxf(v0[j], 0.f), b = fmaxf(v1[j], 0.f); v0[j] = a * a; v1[j] = b * b; }
                    *(u32x4*)(rowp + bj * HALF) = pack8(v0, v1); } }
    }
};
struct EpiPe {
    static constexpr bool PERM = true, AFTER_DRAIN = false, MIDSCALE = false;
    bf16* PE;
    DI void operator()(const f32x4 (&acc)[2][2][4][2], const Unit& u, int wr, int wc, int fr, int fq) const {
        const int row0 = u.pm * 256 + wr * 64 + fr, col0 = u.pn * 256 + wc * 32 + 8 * fq;
#pragma unroll
        for (int ai = 0; ai < 2; ++ai)
#pragma unroll
            for (int m = 0; m < 4; ++m) { bf16* rowp = PE + (size_t)(row0 + ai * HALF + m * 16) * D + col0;
#pragma unroll
                for (int bj = 0; bj < 2; ++bj) *(u32x4*)(rowp + bj * HALF) = pack8(acc[ai][bj][m][0], acc[ai][bj][m][1]); }
    }
};
template <bool GATED, bool XF32> struct EpiRes {
    static constexpr bool PERM = true, AFTER_DRAIN = true, MIDSCALE = false;
    const float* xin32; const bf16* xin16; bf16* XBout; float* SS; const bf16* PE; const float* SSr; bool dry; XcdBarrier bar;
    DI void fused(f32x4 (&acc)[2][2][4][2], const Unit& u, int wr, int wc, int fr, int fq, LAS unsigned char* lds, int wid, int lane) const {
        const int row0 = u.pm * 256 + wr * 64 + fr, col0 = u.pn * 256 + wc * 32 + 8 * fq;
        LAS float* P = (LAS float*)lds;
        float rs[2][4];
        if (GATED) { load_rs8(SSr, row0, rs); xcd_barrier(bar, wid == 0 && lane == 0); }
#pragma unroll
        for (int ai = 0; ai < 2; ++ai)
#pragma unroll
            for (int m = 0; m < 4; ++m) { const size_t r = (size_t)(row0 + ai * HALF + m * 16); float ss = 0.f;
#pragma unroll
                for (int bj = 0; bj < 2; ++bj) { const size_t o = r * D + col0 + bj * HALF;
                    f32x4 x0, x1, v0 = acc[ai][bj][m][0], v1 = acc[ai][bj][m][1];
                    if (XF32) { x0 = *(const f32x4*)(xin32 + o); x1 = *(const f32x4*)(xin32 + o + 4); } else unpack8(*(const u32x4*)(xin16 + o), x0, x1);
                    if (GATED) { f32x4 p0, p1; unpack8(*(const u32x4*)(PE + o), p0, p1); const float rr = rs[ai][m];
#pragma unroll
                        for (int j = 0; j < 4; ++j) { v0[j] = p0[j] * sigm(v0[j] * rr); v1[j] = p1[j] * sigm(v1[j] * rr); } }
                    x0 += v0; x1 += v1;
                    if (!dry) *(u32x4*)(XBout + o) = pack8(x0, x1);
                    ss += ((x0[0] * x0[0] + x0[1] * x0[1]) + (x0[2] * x0[2] + x0[3] * x0[3])) + ((x1[0] * x1[0] + x1[1] * x1[1]) + (x1[2] * x1[2] + x1[3] * x1[3])); }
                ss += swz_xor<16>(ss); ss = sum_halves(ss);
                if (fq == 0) P[(ai * HALF + wr * 64 + m * 16 + fr) * 4 + wc] = ss;
                if (m & 1) MEMFENCE(); }
        __syncthreads();
        if (wid < 4 && !dry) { const int row = wid * 64 + lane; const f32x4 p = *(const LAS f32x4*)(P + row * 4);
            SS[(size_t)(u.pm * 256 + row) * 4 + u.pn] = (p[0] + p[1]) + (p[2] + p[3]); }
        __syncthreads();
    }
};


namespace att {
typedef short s16x4 __attribute__((ext_vector_type(4)));
typedef float f32x16 __attribute__((ext_vector_type(16)));
typedef LAS const char* lds_cptr;
#define SBAR() __builtin_amdgcn_sched_barrier(0)
#define MFMA32(a, b, c) __builtin_amdgcn_mfma_f32_32x32x16_bf16((a), (b), (c), 0, 0, 0)
DI int crow(int r, int hi) { return (r & 3) + 8 * (r >> 2) + 4 * hi; }
DI void qkt(f32x16& p0, f32x16& p1, lds_cptr Kslot, const bf16x8* qr, int r32, int hi) {
    const lds_cptr kb = Kslot + hi * 1024 + r32 * 16;
    f32x16 z0 = {}, z1 = {};
#pragma unroll
    for (int d0 = 0; d0 < 4; ++d0) {
        const bf16x8 b0 = *(const LAS bf16x8*)(kb + d0 * 2048), b1 = *(const LAS bf16x8*)(kb + d0 * 2048 + 512);
        z0 = MFMA32(b0, qr[d0], z0); z1 = MFMA32(b1, qr[d0], z1); }
    p0 = z0; p1 = z1;
}
DI void pv(f32x16* o, int vb, bf16x8 pa0, bf16x8 pa1, bf16x8 pa2, bf16x8 pa3) {
#pragma unroll
    for (int d0 = 0; d0 < 2; ++d0) { s16x4 lo[4], hi[4];
#pragma unroll
        for (int ks = 0; ks < 4; ++ks) {
            asm volatile("ds_read_b64_tr_b16 %0,%1 offset:%c2" : "=&v"(lo[ks]) : "v"(vb), "i"(d0 * 4096 + ks * 1024) : "memory");
            asm volatile("ds_read_b64_tr_b16 %0,%1 offset:%c2" : "=&v"(hi[ks]) : "v"(vb), "i"(d0 * 4096 + ks * 1024 + 512) : "memory"); }
        asm volatile("s_waitcnt lgkmcnt(0)" ::: "memory"); SBAR();
#define PK(k) (bf16x8){lo[k][0], lo[k][1], lo[k][2], lo[k][3], hi[k][0], hi[k][1], hi[k][2], hi[k][3]}
        o[d0] = MFMA32(pa0, PK(0), o[d0]); o[d0] = MFMA32(pa1, PK(1), o[d0]); o[d0] = MFMA32(pa2, PK(2), o[d0]); o[d0] = MFMA32(pa3, PK(3), o[d0]);
#undef PK
    }
}
DI int vlane_ofs(int lane, int hi) { return ((lane >> 4) & 1) * 32 + (lane & 3) * 8 + (4 * hi + ((lane & 15) >> 2)) * 64; }
DI float other_half(float v, int hi) { auto rr = __builtin_amdgcn_permlane32_swap(__float_as_uint(v), __float_as_uint(v), false, false); return __uint_as_float(hi ? rr[0] : rr[1]); }
DI void pack_p(const f32x16& p0, const f32x16& p1, u32x4& w0, u32x4& w1, u32x4& w2, u32x4& w3) {
    w0 = (u32x4){cvtpk(p0[0], p0[1]), cvtpk(p0[2], p0[3]), cvtpk(p0[4], p0[5]), cvtpk(p0[6], p0[7])};
    w1 = (u32x4){cvtpk(p0[8], p0[9]), cvtpk(p0[10], p0[11]), cvtpk(p0[12], p0[13]), cvtpk(p0[14], p0[15])};
    w2 = (u32x4){cvtpk(p1[0], p1[1]), cvtpk(p1[2], p1[3]), cvtpk(p1[4], p1[5]), cvtpk(p1[6], p1[7])};
    w3 = (u32x4){cvtpk(p1[8], p1[9]), cvtpk(p1[10], p1[11]), cvtpk(p1[12], p1[13]), cvtpk(p1[14], p1[15])};
}
DI void store_o(const f32x16* o, const float* scale, LAS bf16* stg, bf16* Ow, int pitch, int lane, int r32, int hi) {
#pragma unroll
    for (int r = 0; r < 16; ++r) { const int orow = crow(r, hi); const float sc = scale ? scale[r] : 1.0f;
#pragma unroll
        for (int d0 = 0; d0 < 2; ++d0) stg[orow * 64 + d0 * 32 + r32] = (bf16)f2bf(o[d0][r] * sc); }
    asm volatile("s_waitcnt lgkmcnt(0)" ::: "memory");
#pragma unroll
    for (int i = 0; i < 4; ++i) { const int row = i * 8 + (lane >> 3), ch = lane & 7; const u32x4 v = *(const LAS u32x4*)(stg + row * 64 + ch * 8); *(u32x4*)(Ow + (long)row * pitch + ch * 8) = v; }
}

DI void sb_half(f32x16& p, float& T, int kb, int qabs, bool need_mask, int hi, float oth) {
    f32x16 lb;
#pragma unroll
    for (int r = 0; r < 16; ++r) { const float y = p[r], L = __builtin_amdgcn_logf(1.0f + __builtin_amdgcn_exp2f(-__builtin_fabsf(y))); lb[r] = __builtin_fminf(y, 0.f) - L; p[r] = __builtin_fminf(-y, 0.f) - L; }
    if (need_mask) {
#pragma unroll
        for (int r = 0; r < 16; ++r) { const int key = kb + (r & 3) + 8 * (r >> 2); if (key >= qabs) { p[r] = 0.f; lb[r] = -INFINITY; } } }
    float gs[4], og[4];
#pragma unroll
    for (int g = 0; g < 4; ++g) gs[g] = (p[4 * g] + p[4 * g + 1]) + (p[4 * g + 2] + p[4 * g + 3]);
#pragma unroll
    for (int g = 0; g < 4; ++g) og[g] = other_half(gs[g], hi);
#pragma unroll
    for (int g = 3; g >= 0; --g) { float S = T + oth * og[g]; T += gs[g] + og[g];
        const float a3 = __builtin_amdgcn_exp2f(lb[4 * g + 3] + S); S += p[4 * g + 3];
        const float a2 = __builtin_amdgcn_exp2f(lb[4 * g + 2] + S); S += p[4 * g + 2];
        const float a1 = __builtin_amdgcn_exp2f(lb[4 * g + 1] + S); S += p[4 * g + 1];
        const float a0 = __builtin_amdgcn_exp2f(lb[4 * g] + S);
        p[4 * g] = a0; p[4 * g + 1] = a1; p[4 * g + 2] = a2; p[4 * g + 3] = a3; }
}
DI void sb_math(f32x16& p0, f32x16& p1, float& carry, int kb, int qabs, bool need_mask, int hi) {
    const float oth = hi ? 0.f : 1.f;
    float T = carry;
    sb_half(p1, T, kb + 32, qabs, need_mask, hi, oth);
    sb_half(p0, T, kb, qabs, need_mask, hi, oth);
    carry = T;
}
constexpr float SB_DONE = -152.0f;
DI void load_k(bf16x8 (&kf)[8], const bf16* ksrc, int jt) {
    const bf16* p = ksrc + (long)jt * 64 * NQKV;
#pragma unroll
    for (int d0 = 0; d0 < 4; ++d0) { kf[2 * d0] = *(const bf16x8*)(p + 16 * d0); kf[2 * d0 + 1] = *(const bf16x8*)(p + (long)32 * NQKV + 16 * d0); }
}
DI void load_v(u32x4 (&vr)[8], const bf16* vsrc, int jt) {
    const bf16* p = vsrc + (long)jt * 64 * NQKV;
#pragma unroll
    for (int i = 0; i < 8; ++i) vr[i] = *(const u32x4*)(p + (long)(16 * (i & 3)) * NQKV + 32 * (i >> 2));
}
DI void dma_v(const bf16* vsrc, int jt, LAS char* slot) {
    const bf16* p = vsrc + (long)jt * 64 * NQKV;
#pragma unroll
    for (int i = 0; i < 8; ++i) __builtin_amdgcn_global_load_lds((const GAS unsigned*)(p + (long)(16 * (i & 3)) * NQKV + 32 * (i >> 2)), (LAS unsigned*)(slot + i * 1024), 16, 0, 0);
}
DI void store_v(const u32x4 (&vr)[8], LAS char* slot, int lane) {
#pragma unroll
    for (int i = 0; i < 8; ++i) *(LAS u32x4*)(slot + i * 1024 + lane * 16) = vr[i];
}
DI void qkt_r(f32x16& p0, f32x16& p1, const bf16x8 (&kf)[8], const bf16x8* qr) {
    f32x16 z0 = {}, z1 = {};
#pragma unroll
    for (int d0 = 0; d0 < 4; ++d0) { z0 = MFMA32(kf[2 * d0], qr[d0], z0); z1 = MFMA32(kf[2 * d0 + 1], qr[d0], z1); }
    p0 = z0; p1 = z1;
}
template <bool EARLY> DI void sbw_unit(int b, int h, int qb32, const bf16* QKV, bf16* ATT, LAS char* wl, int lane) {
    const int r32 = lane & 31, hi = lane >> 5;
    const long rowbase = (long)b * SEQ; const int qs = qb32 * 32, qabs = qs + r32;
    const bf16* Qw = QKV + (rowbase + qs) * NQKV + h * 64;
    const bf16* ksrc = QKV + rowbase * NQKV + 512 + h * 64 + (long)r32 * NQKV + hi * 8;
    const bf16* vsrc = QKV + rowbase * NQKV + 1024 + h * 64 + (long)(lane >> 2) * NQKV + (lane & 3) * 8;
    bf16x8 qr[4];
#pragma unroll
    for (int d0 = 0; d0 < 4; ++d0) qr[d0] = *(const bf16x8*)(Qw + (long)r32 * NQKV + d0 * 16 + hi * 8);
    f32x16 o[2]; o[0] = f32x16{}; o[1] = f32x16{};
    float carry = 0.f;
    int jt = (qs + 31) >> 6, slot = 0;
    const int vofs = (int)(uintptr_t)wl + vlane_ofs(lane, hi);
    bf16x8 kf[8];
    load_k(kf, ksrc, jt); dma_v(vsrc, jt, wl);
    for (;;) {
        f32x16 p0, p1; qkt_r(p0, p1, kf, qr);
        if (jt > 0) { load_k(kf, ksrc, jt - 1); dma_v(vsrc, jt - 1, wl + (slot ^ 1) * 8192); }
        sb_math(p0, p1, carry, 64 * jt + 4 * hi, qabs, 64 * jt + 63 >= qs, hi);
        u32x4 w0, w1, w2, w3; pack_p(p0, p1, w0, w1, w2, w3);
        if (jt > 0) asm volatile("s_waitcnt vmcnt(16)" ::: "memory"); else asm volatile("s_waitcnt vmcnt(0)" ::: "memory");
        pv(o, vofs + slot * 8192, __builtin_bit_cast(bf16x8, w0), __builtin_bit_cast(bf16x8, w1), __builtin_bit_cast(bf16x8, w2), __builtin_bit_cast(bf16x8, w3));
        bool done = jt == 0;
        if (EARLY) done = done || (__all(carry < SB_DONE) != 0);
        if (done) break;
        slot ^= 1; --jt;
    }
    asm volatile("s_waitcnt vmcnt(0)" ::: "memory");
    asm volatile("s_waitcnt lgkmcnt(0)" ::: "memory");
    store_o(o, nullptr, (LAS bf16*)wl, ATT + (rowbase + qs) * D + h * 64, D, lane, r32, hi);
    asm volatile("s_waitcnt lgkmcnt(0)" ::: "memory");
}

DI void swaw_unit(int b, int h, int qb32, int layer, const bf16* QKV, const float* BT, bf16* ATT, LAS char* wl, LAS float* btl, LAS float* wsf, int lane) {
    const int r32 = lane & 31, hi = lane >> 5, kvh = h >> 2;
    const long rowbase = (long)b * SEQ; const int qs = qb32 * 32, qabs = qs + r32;
    const bf16* Qw = QKV + (rowbase + qs) * NQKV + 1536 + h * 64;
    const bf16* ksrc = QKV + rowbase * NQKV + 2048 + kvh * 64 + (long)r32 * NQKV + hi * 8;
    const bf16* vsrc = QKV + rowbase * NQKV + 2176 + kvh * 64 + (long)(lane >> 2) * NQKV + (lane & 3) * 8;
    btl[lane] = BT[h * 128 + lane]; btl[64 + lane] = BT[h * 128 + 64 + lane];
    const float sink = BT[1024 + layer * 8 + h];
    bf16x8 qr[4];
#pragma unroll
    for (int d0 = 0; d0 < 4; ++d0) qr[d0] = *(const bf16x8*)(Qw + (long)r32 * NQKV + d0 * 16 + hi * 8);
    const int jlo = (qs - 127) >> 6;
    const int vofs = (int)(uintptr_t)wl + vlane_ofs(lane, hi);
    asm volatile("s_waitcnt lgkmcnt(0)" ::: "memory");
    bf16x8 kf[8];
    float m = -INFINITY;
#pragma unroll 1
    for (int ii = 0; ii < 3; ++ii) { const int jt = jlo + ii; if (jt < 0) continue;
        load_k(kf, ksrc, jt);
        f32x16 p0, p1; qkt_r(p0, p1, kf, qr);
        const int db = qabs - (64 * jt + 4 * hi);
#pragma unroll
        for (int r = 0; r < 16; ++r) { const int d0_ = db - ((r & 3) + 8 * (r >> 2)), d1_ = d0_ - 32;
            const float s0 = p0[r] + btl[d0_ & 127], s1 = p1[r] + btl[d1_ & 127];
            if ((unsigned)d0_ < 128u) m = __builtin_fmaxf(m, s0);
            if ((unsigned)d1_ < 128u) m = __builtin_fmaxf(m, s1); } }
    m = __builtin_fmaxf(m, other_half(m, hi)); m = __builtin_fmaxf(m, sink);
    f32x16 o[2]; o[0] = f32x16{}; o[1] = f32x16{};
    float l = 0.f;
#pragma unroll 1
    for (int ii = 0; ii < 3; ++ii) { const int jt = jlo + ii; if (jt < 0) continue;
        u32x4 vr[8];
        load_k(kf, ksrc, jt); load_v(vr, vsrc, jt);
        f32x16 p0, p1; qkt_r(p0, p1, kf, qr);
        const int db = qabs - (64 * jt + 4 * hi);
#pragma unroll
        for (int r = 0; r < 16; ++r) { const int d0_ = db - ((r & 3) + 8 * (r >> 2)), d1_ = d0_ - 32;
            const float e0 = __builtin_amdgcn_exp2f(p0[r] + btl[d0_ & 127] - m), e1 = __builtin_amdgcn_exp2f(p1[r] + btl[d1_ & 127] - m);
            p0[r] = (unsigned)d0_ < 128u ? e0 : 0.f; p1[r] = (unsigned)d1_ < 128u ? e1 : 0.f; l += p0[r] + p1[r]; }
        u32x4 w0, w1, w2, w3; pack_p(p0, p1, w0, w1, w2, w3);
        store_v(vr, wl + (ii & 1) * 8192, lane);
        asm volatile("s_waitcnt lgkmcnt(0)" ::: "memory");
        pv(o, vofs + (ii & 1) * 8192, __builtin_bit_cast(bf16x8, w0), __builtin_bit_cast(bf16x8, w1), __builtin_bit_cast(bf16x8, w2), __builtin_bit_cast(bf16x8, w3)); }
    l += other_half(l, hi); l += __builtin_amdgcn_exp2f(sink - m);
    if (hi == 0) wsf[r32] = 1.0f / l;
    asm volatile("s_waitcnt lgkmcnt(0)" ::: "memory");
    float rli[16];
#pragma unroll
    for (int r = 0; r < 16; ++r) rli[r] = wsf[crow(r, hi)];
    store_o(o, rli, (LAS bf16*)wl, ATT + (rowbase + qs) * D + 512 + h * 64, D, lane, r32, hi);
    asm volatile("s_waitcnt lgkmcnt(0)" ::: "memory");
}
#undef SBAR
#undef MFMA32
}


DI void conv_w(const float* W, const float* g, bf16* WT, int K, int N, int ldk, int koff, bool perm_gate, LAS float* scr, int gw, int NGW, int lane) {
    const int nblk = N / 32, nitems = (K / 64) * nblk;
    for (int item = gw; item < nitems; item += NGW) {
        const int kb = item / nblk, nb = item % nblk, k0 = 64 * kb, n0 = 32 * nb;
        int nd = n0;
        if (perm_gate && n0 >= NQKV) { const int c = n0 - NQKV; nd = c < 1024 ? NQKV + 256 * (c >> 7) + (c & 127) : NQKV + 256 * ((c - 1024) >> 7) + 128 + ((c - 1024) & 127); }
        float wv_[32];
#pragma unroll
        for (int i = 0; i < 32; ++i) wv_[i] = W[(size_t)(k0 + 2 * i + (lane >> 5)) * N + n0 + (lane & 31)];
        if (g) {
#pragma unroll
            for (int i = 0; i < 32; ++i) wv_[i] *= g[k0 + 2 * i + (lane >> 5)]; }
#pragma unroll
        for (int i = 0; i < 32; ++i) scr[(2 * i + (lane >> 5)) * 33 + (lane & 31)] = wv_[i];
        asm volatile("s_waitcnt lgkmcnt(0)" ::: "memory");
        const int c = lane & 7;
#pragma unroll
        for (int j = 0; j < 4; ++j) { const int n = (lane >> 3) + 8 * j; const LAS float* s = scr + (8 * c) * 33 + n;
            u32x4 o; o.x = pk2(s[0 * 33], s[1 * 33]); o.y = pk2(s[2 * 33], s[3 * 33]); o.z = pk2(s[4 * 33], s[5 * 33]); o.w = pk2(s[6 * 33], s[7 * 33]);
            *(u32x4*)(WT + (size_t)(nd + n) * ldk + koff + k0 + 8 * c) = o; }
        asm volatile("s_waitcnt lgkmcnt(0)" ::: "memory");
    }
}
DI void rownorm_rows(const float* x, bf16* XB, float* SS, int gw, int NGW, int lane) {
    for (int row = gw; row < M; row += 2 * NGW) {
        const int row2 = row + NGW < M ? row + NGW : row;
        const f32x4* xa = (const f32x4*)(x + (size_t)row * D) + lane; const f32x4* xb = (const f32x4*)(x + (size_t)row2 * D) + lane;
        f32x4 va[4], vb[4];
#pragma unroll
        for (int j = 0; j < 4; ++j) { va[j] = xa[64 * j]; vb[j] = xb[64 * j]; }
        u32x2* oa = (u32x2*)(XB + (size_t)row * D) + lane; u32x2* ob = (u32x2*)(XB + (size_t)row2 * D) + lane;
        float sa = 0.f, sb = 0.f;
#pragma unroll
        for (int j = 0; j < 4; ++j) { const f32x4 v = va[j], w = vb[j];
            sa += (v[0] * v[0] + v[1] * v[1]) + (v[2] * v[2] + v[3] * v[3]); sb += (w[0] * w[0] + w[1] * w[1]) + (w[2] * w[2] + w[3] * w[3]);
            u32x2 p; p.x = cvtpk(v[0], v[1]); p.y = cvtpk(v[2], v[3]); oa[64 * j] = p; u32x2 q; q.x = cvtpk(w[0], w[1]); q.y = cvtpk(w[2], w[3]); ob[64 * j] = q; }
        sa = wave_sum(sa); sb = wave_sum(sb);
        if (lane == 0) { *(f32x4*)(SS + (size_t)row * 4) = (f32x4){sa, 0.f, 0.f, 0.f}; *(f32x4*)(SS + (size_t)row2 * 4) = (f32x4){sb, 0.f, 0.f, 0.f}; }
    }
}
DI void final_rows(const bf16* xb, float* out, const float* SS, const float* gf, int gw, int NGW, int lane, bool dry) {
    for (int row = gw; row < M; row += NGW) {
        const u32x4* xr = (const u32x4*)(xb + (size_t)row * D) + lane; f32x4* orow = (f32x4*)(out + (size_t)row * D) + 2 * lane; const f32x4* g4 = (const f32x4*)gf + 2 * lane;
        const float r = rs_from(*(const f32x4*)(SS + (size_t)row * 4));
#pragma unroll
        for (int j = 0; j < 2; ++j) { f32x4 a, b; unpack8(xr[64 * j], a, b); a = (a * r) * g4[128 * j]; b = (b * r) * g4[128 * j + 1];
            if (!dry) { orow[128 * j] = a; orow[128 * j + 1] = b; } else asm volatile("" :: "v"(a), "v"(b)); }
    }
}
DI int t5_bucket(int d) {
    if (d < 16) return d;
    const int large = 16 + (int)(logf((float)d / 16.0f) / 2.0794415416798357f * 16.0f);
    return large < 31 ? large : 31;
}

#ifndef PROBE_TS
#define PROBE_TS -1
#endif
#ifndef MK_N_LAUNCHES
#define MK_N_LAUNCHES 1
#endif
constexpr int NPH = 16;
struct Args { const float* in[16]; float* out; unsigned char* ws; int ph_lo, ph_hi; };
static_assert(sizeof(Args) == 16 * 8 + 8 + 8 + 8, "Args has no padding");

typedef const __attribute__((address_space(4))) Args* KArgs;
struct PeOrder {
    int nM, nN, nwg, G, c, skip;
    DI void init(int M_, int N_, int G_, int c_, int skip_) { nM = M_ / 256; nN = N_ / 256; nwg = nM * nN; G = G_; c = c_; skip = skip_ < G_ ? skip_ : 0; }
    DI bool next(int i, pg8::Unit& u) const { if (c < skip) return false; const int L = i * (G - skip) + (c - skip); if (L >= nwg) return false; u.pm = L / nN; u.pn = L % nN; return true; }
    DI void a_ready(const pg8::Unit&) const {}
    DI void done(const pg8::Unit&) const {}
};
DI KArgs kargs() { KArgs p = (KArgs)__builtin_amdgcn_kernarg_segment_ptr(); asm volatile("" : "+s"(p)); return p; }
struct Ctx { int tid, lane, wave, G, bx, vcu, gw, NGW; };
DI Ctx ctx(int wv) { Ctx c; int z = 0; asm volatile("" : "+v"(z)); const int ln = __builtin_amdgcn_mbcnt_hi(~0u, __builtin_amdgcn_mbcnt_lo(~0u, z)); int t = wv * 64 + ln; asm volatile("" : "+v"(t));
    int b = blockIdx.x; asm volatile("" : "+s"(b)); c.tid = t; c.lane = ln; c.wave = wv;
    c.G = gridDim.x; c.bx = b; c.vcu = (c.G % 8 == 0) ? (b % 8) * (c.G / 8) + b / 8 : b; c.gw = c.vcu * NWAVES + c.wave; c.NGW = c.G * NWAVES; return c; }
#define WSP(T, off) ((T*)(A->ws + (off)))
__global__ void __launch_bounds__(NWAVES * 64, 2) mk_fwd(Args args_unused) {
    extern __shared__ __attribute__((aligned(16))) unsigned char lds_raw[];
    LAS unsigned char* lds = (LAS unsigned char*)lds_raw;
    volatile LAS unsigned* MISC = (volatile LAS unsigned*)(lds + MISC_OFF);
    const int wv = __builtin_amdgcn_readfirstlane(threadIdx.x >> 6);
    for (int u = threadIdx.x; u < (LDS_BYTES - RING_BYTES) / 4; u += NWAVES * 64) ((LAS unsigned*)(lds + RING_BYTES))[u] = 0u;
    __syncthreads();
    int lo, hi;
    if (PROBE_TS >= 0 && blockIdx.x == 0 && threadIdx.x == 0) { KArgs A = kargs(); WSP(unsigned long long, WS_CTL + 32768)[31] = __builtin_amdgcn_s_memrealtime(); }
    XcdBarrier bar;
    { KArgs A = kargs(); lo = A->ph_lo; hi = A->ph_hi; bar.bar = WSP(unsigned, WS_CTL) + CW_BAR; bar.x = 0; bar.st = nullptr;
      if (MK_N_LAUNCHES == 1) bar = xcd_barrier_post(WSP(unsigned, WS_CTL) + CW_BAR, MISC + 8); }
#define IN(k) (lo <= (k) && (k) < hi)
#define STAMP(k) do { if (PROBE_TS >= 0 && blockIdx.x == 0) { const Ctx cs_ = ctx(wv); if (cs_.tid == 0) { KArgs A = kargs(); WSP(unsigned long long, WS_CTL + 32768)[(k)] = __builtin_amdgcn_s_memrealtime(); } } } while (0)
#ifndef PROBE_REP
#define PROBE_REP 0
#endif
#define REP_BEGIN(j) for (int rep_ = 0; rep_ <= ((PROBE_REP >> (j)) & 1); ++rep_) {
#define REP_END(j) if (rep_ < ((PROBE_REP >> (j)) & 1)) { XcdBarrier b_ = bar; asm volatile("" : "+s"(b_.bar)); const Ctx cb_ = ctx(wv); xcd_barrier(b_, cb_.tid == 0); } }
#define SEAM(k) do { if (IN(k) && IN((k) + 1)) { XcdBarrier b_ = bar; asm volatile("" : "+s"(b_.bar)); const Ctx cb_ = ctx(wv); xcd_barrier(b_, cb_.tid == 0); } STAMP(k); } while (0)
#define CONV(W, g, WT, K, N, ldk, koff, perm) conv_w((W), (g), (WT), (K), (N), (ldk), (koff), (perm), (LAS float*)(lds + c.wave * 16384), c.gw, c.NGW, c.lane)

    REP_BEGIN(7)
    if (IN(0)) {
        KArgs A = kargs(); const Ctx c = ctx(wv);
        float* BT = WSP(float, WS_BT);
        if (c.bx == 0) { const float* rel_bias = A->in[15]; const float* sinks = A->in[14];
            for (int i = c.tid; i < 8 * 128; i += NWAVES * 64) { const int h = i >> 7, d = i & 127; BT[i] = rel_bias[t5_bucket(d) * 8 + h] * LOG2E; }
            if (c.tid < 16) BT[1024 + c.tid] = sinks[c.tid] * LOG2E; }
        CONV(A->in[2], A->in[10], WSP(bf16, WS_WIN), D, NIN, D, 0, true);
        rownorm_rows(A->in[0], WSP(bf16, WS_XB), WSP(float, WS_SS), c.gw, c.NGW, c.lane);
        __syncthreads();
    }
    REP_END(7)
    SEAM(0);
#pragma unroll 1
    for (int l = 0; l < DEPTH; ++l) {
        const int pb = 1 + 7 * l;
#define SSA WSP(float, WS_SS + (l == 0 ? 0 : (size_t)M * 16))
#define SSB WSP(float, WS_SS + (l == 0 ? (size_t)M * 16 : 0))
        REP_BEGIN(0)
        if (IN(pb)) {
            KArgs A = kargs(); const Ctx c = ctx(wv);
            pg8::Gemm g{WSP(bf16, WS_XB), WSP(bf16, WS_WIN), M, NIN, D}; pg8::StaticOrder S; S.init(M, NIN, c.G, c.bx);
            EpiIn E{SSA, WSP(bf16, WS_QKV), WSP(bf16, WS_GATE)};
            pg8::gemm_phase<EpiIn, pg8::StaticOrder, true, true>(lds, g, S, E, c.tid);
        }
        if (IN(pb)) {
            KArgs A = kargs(); const Ctx c = ctx(wv);
            const int skip = (c.G == 256) ? ((M / 256) * (NIN / 256)) % 256 : 0;
            if (c.bx >= skip) {
                const int gw2 = (c.bx - skip) * NWAVES + c.wave, NGW2 = (c.G - skip) * NWAVES; LAS float* scr = (LAS float*)(lds + c.wave * 16384);
                conv_w(A->in[3] + (size_t)l * 512 * D, nullptr, WSP(bf16, WS_WUP), 512, D, D, 0, false, scr, gw2, NGW2, c.lane);
                conv_w(A->in[4] + (size_t)l * 512 * D, nullptr, WSP(bf16, WS_WUP), 512, D, D, 512, false, scr, gw2, NGW2, c.lane);
                conv_w(A->in[5] + (size_t)l * D * D, nullptr, WSP(bf16, WS_WO), D, D, D, 0, false, scr, gw2, NGW2, c.lane);
                conv_w(A->in[6] + (size_t)l * D * FF, A->in[11] + l * D, WSP(bf16, WS_WFF1), D, FF, D, 0, false, scr, gw2, NGW2, c.lane);
                conv_w(A->in[7] + (size_t)l * FF * D, nullptr, WSP(bf16, WS_WFF2), FF, D, FF, 0, false, scr, gw2, NGW2, c.lane);
                conv_w(A->in[8] + (size_t)l * PLE * D, nullptr, WSP(bf16, WS_WPE), PLE, D, PLE, 0, false, scr, gw2, NGW2, c.lane);
                conv_w(A->in[9] + (size_t)l * D * D, A->in[12] + l * D, WSP(bf16, WS_WPG), D, D, D, 0, false, scr, gw2, NGW2, c.lane);
                if (l == 0) { const float* p_in = A->in[1]; bf16* PB = WSP(bf16, WS_PB);
                    for (size_t i = (size_t)(c.bx - skip) * (NWAVES * 64) + c.tid; i < (size_t)DEPTH * M * PLE / 4; i += (size_t)(c.G - skip) * NWAVES * 64) {
                        const f32x4 v = ((const f32x4*)p_in)[i]; u32x2 o; o.x = cvtpk(v[0], v[1]); o.y = cvtpk(v[2], v[3]); ((u32x2*)PB)[i] = o; } }
            }
            __syncthreads();
        }
        REP_END(0)
        SEAM(pb);
        REP_BEGIN(1)
        if (IN(pb + 1)) {
            KArgs A = kargs(); const Ctx c = ctx(wv);
            if (l == 0) { CONV(A->in[2] + (size_t)D * NIN, A->in[10] + D, WSP(bf16, WS_WIN), D, NIN, D, 0, true); __syncthreads(); }
            __syncthreads();
            { LAS char* wl = (LAS char*)lds + c.wave * 16384;
              LAS float* btl = (LAS float*)(lds + RING_BYTES + 1024) + c.wave * 192; LAS float* wsf = btl + 128;
              for (int u = c.gw; u < BATCH * 8 * (SEQ / 32); u += c.NGW) { const int bh = u >> 7, qb = u & 127; att::sbw_unit<true>(bh >> 3, bh & 7, qb, WSP(bf16, WS_QKV), WSP(bf16, WS_ATT), wl, c.lane); }
              for (int u = c.gw; u < BATCH * 8 * (SEQ / 32); u += c.NGW) { const int bh = u >> 7, qb = u & 127; att::swaw_unit(bh >> 3, bh & 7, qb, l, WSP(bf16, WS_QKV), WSP(float, WS_BT), WSP(bf16, WS_ATT), wl, btl, wsf, c.lane); } }
        }
        REP_END(1)
        SEAM(pb + 1);
        REP_BEGIN(2)
        if (IN(pb + 2)) {
            KArgs A = kargs(); const Ctx c = ctx(wv);
            pg8::Gemm g{WSP(bf16, WS_ATT), WSP(bf16, WS_WUP), M, D, D}; pg8::StaticOrder S; S.init(M, D, c.G, c.bx);
            EpiUp E{WSP(bf16, WS_GATE), WSP(bf16, WS_MRG)};
            pg8::gemm_phase<EpiUp, pg8::StaticOrder, true, true>(lds, g, S, E, c.tid);
        }
        REP_END(2)
        SEAM(pb + 2);
        for (int rep_ = 0; rep_ <= (l == 0 ? ((PROBE_REP >> 3) & 1) : 0); ++rep_) {
        if (IN(pb + 3)) {
            KArgs A = kargs(); const Ctx c = ctx(wv);
            if (c.G == 256) {
                pg8::Gemm g{WSP(bf16, WS_MRG), WSP(bf16, WS_WO), M, D, D}; pg8::StaticOrder S; S.init(M, D, c.G, c.bx);
                if (l == 0) { EpiRes<false, true> E{A->in[0], nullptr, WSP(bf16, WS_XB), SSB, nullptr, nullptr, false, bar};
                    pg8::gemm_phase<EpiRes<false, true>, pg8::StaticOrder, false, true>(lds, g, S, E, c.tid); }
                else { EpiRes<false, false> E{nullptr, WSP(bf16, WS_XB), WSP(bf16, WS_XB), SSB, nullptr, nullptr, false, bar};
                    pg8::gemm_phase<EpiRes<false, false>, pg8::StaticOrder, false, true>(lds, g, S, E, c.tid); }
            }
        }
        if (rep_ < (l == 0 ? ((PROBE_REP >> 3) & 1) : 0)) { XcdBarrier b_ = bar; asm volatile("" : "+s"(b_.bar)); const Ctx cb_ = ctx(wv); xcd_barrier(b_, cb_.tid == 0); } }
        SEAM(pb + 3);
        REP_BEGIN(4)
        if (IN(pb + 4)) {
            KArgs A = kargs(); const Ctx c = ctx(wv);
            { pg8::Gemm g{WSP(bf16, WS_XB), WSP(bf16, WS_WFF1), M, FF, D}; pg8::StaticOrder S; S.init(M, FF, c.G, c.bx);
              EpiFf1 E{SSB, WSP(bf16, WS_U)};
              pg8::gemm_phase<EpiFf1, pg8::StaticOrder, true, true>(lds, g, S, E, c.tid); }
        }
        if (IN(pb + 4)) {
            KArgs A = kargs(); const Ctx c = ctx(wv);
            { pg8::Gemm g{WSP(bf16, WS_PB) + (size_t)l * M * PLE, WSP(bf16, WS_WPE), M, D, PLE}; pg8::StaticOrder S; S.init(M, D, c.G, c.bx);
              EpiPe E{WSP(bf16, WS_PE)};
              pg8::gemm_phase<EpiPe, pg8::StaticOrder, true, true>(lds, g, S, E, c.tid); }
        }
        REP_END(4)
        SEAM(pb + 4);
        if (IN(pb + 5)) {
            KArgs A = kargs(); const Ctx c = ctx(wv);
            if (c.G == 256) {
                pg8::Gemm g{WSP(bf16, WS_U), WSP(bf16, WS_WFF2), M, D, FF}; pg8::StaticOrder S; S.init(M, D, c.G, c.bx);
                for (int rep_ = ((PROBE_REP >> 5) & 1); rep_ >= 0; --rep_) { EpiRes<false, false> E{nullptr, WSP(bf16, WS_XB), WSP(bf16, WS_XB), SSA, nullptr, nullptr, rep_ != 0, bar};
                pg8::gemm_phase<EpiRes<false, false>, pg8::StaticOrder, false, true>(lds, g, S, E, c.tid); }
            }
        }
        SEAM(pb + 5);
        if (IN(pb + 6)) {
            KArgs A = kargs(); const Ctx c = ctx(wv);
            if (c.G == 256) {
                pg8::Gemm g{WSP(bf16, WS_XB), WSP(bf16, WS_WPG), M, D, D}; pg8::StaticOrder S; S.init(M, D, c.G, c.bx);
                for (int rep_ = ((PROBE_REP >> 6) & 1); rep_ >= 0; --rep_) { XcdBarrier b_ = bar; asm volatile("" : "+s"(b_.bar)); EpiRes<true, false> E{nullptr, WSP(bf16, WS_XB), WSP(bf16, WS_XB), SSB, WSP(bf16, WS_PE), SSA, rep_ != 0, b_};
                pg8::gemm_phase<EpiRes<true, false>, pg8::StaticOrder, false, true>(lds, g, S, E, c.tid); }
            }
        }
        SEAM(pb + 6);
    }
    if (IN(NPH - 1)) { KArgs A = kargs(); const Ctx c = ctx(wv); for (int rep_ = ((PROBE_REP >> 8) & 1); rep_ >= 0; --rep_) final_rows(WSP(bf16, WS_XB), A->out, WSP(float, WS_SS), A->in[13], c.gw, c.NGW, c.lane, rep_ != 0); }
    if (PROBE_TS >= 0) {
        __syncthreads(); KArgs A = kargs(); const Ctx c = ctx(wv); const unsigned long long* ts = WSP(unsigned long long, WS_CTL + 32768);
        const unsigned long long t1 = __hip_atomic_load(ts + PROBE_TS, __ATOMIC_RELAXED, __HIP_MEMORY_SCOPE_AGENT), t0 = __hip_atomic_load(ts + (PROBE_TS == 0 ? 31 : PROBE_TS - 1), __ATOMIC_RELAXED, __HIP_MEMORY_SCOPE_AGENT);
        const float V = (float)(t1 - t0) * (0.01f / 30.0f);
        for (size_t i = (size_t)c.vcu * (NWAVES * 64) + c.tid; i < (size_t)M * D / 4; i += (size_t)c.G * NWAVES * 64) ((f32x4*)A->out)[i] = (f32x4){V, V, V, V};
    }
#undef IN
#undef SEAM
#undef CONV
}

extern "C" void kernel_launch(void* const* d_in, const int* in_sizes, int n_in, void* d_out, int out_size, void* d_ws, size_t ws_size, hipStream_t stream) {
    static int grid = 0;
    if (grid == 0) {
        if (n_in != 16 || in_sizes[0] != M * D || out_size != M * D || ws_size < WS_END) { fprintf(stderr, "kernel_launch: unexpected shapes (n_in %d, in0 %d, out %d, ws %zu); nothing launched\n", n_in, n_in > 0 ? in_sizes[0] : -1, out_size, ws_size); grid = -1; return; }
        int dev = 0, cus = 0, per_cu = 0;
        if (hipGetDevice(&dev) != hipSuccess || hipDeviceGetAttribute(&cus, hipDeviceAttributeMultiprocessorCount, dev) != hipSuccess) { fprintf(stderr, "kernel_launch: device query failed\n"); grid = -1; return; }
        if (hipFuncSetAttribute((const void*)mk_fwd, hipFuncAttributeMaxDynamicSharedMemorySize, LDS_BYTES) != hipSuccess) { fprintf(stderr, "kernel_launch: hipFuncSetAttribute failed\n"); grid = -1; return; }
        if (hipOccupancyMaxActiveBlocksPerMultiprocessor(&per_cu, (const void*)mk_fwd, NWAVES * 64, LDS_BYTES) != hipSuccess || per_cu < 1) fprintf(stderr, "kernel_launch: note: occupancy query reports %d workgroups per CU\n", per_cu);
        (void)hipGetLastError();
        grid = cus;
        if (grid != 256) fprintf(stderr, "kernel_launch: %d CUs; the single-unit GEMM phases need exactly 256 workgroups\n", grid);
    }
    if (grid < 0) return;
    if (hipMemsetAsync((char*)d_ws + WS_CTL, 0, CTL_ZERO_BYTES, stream) != hipSuccess) { fprintf(stderr, "kernel_launch: memset failed\n"); return; }
    Args a{};
    for (int i = 0; i < 16; ++i) a.in[i] = (const float*)d_in[i];
    a.out = (float*)d_out; a.ws = (unsigned char*)d_ws;
    if (MK_N_LAUNCHES == 1) { a.ph_lo = 0; a.ph_hi = NPH; hipLaunchKernelGGL(mk_fwd, dim3(grid), dim3(NWAVES * 64), LDS_BYTES, stream, a); }
    else for (int li = 0; li < NPH; ++li) { a.ph_lo = li; a.ph_hi = li + 1; hipLaunchKernelGGL(mk_fwd, dim3(grid), dim3(NWAVES * 64), LDS_BYTES, stream, a); }
    const hipError_t le = hipPeekAtLastError();
    if (le != hipSuccess) fprintf(stderr, "kernel_launch: launch failed: %s\n", hipGetErrorName(le));
}
```

```cpp
#include <hip/hip_runtime.h>
#include <cstdio>
#include <cstdint>
#define LAS __attribute__((address_space(3)))

namespace pg8 {
#define PG8_LAS __attribute__((address_space(3)))
typedef unsigned short bf16_t;
typedef short bf16x8 __attribute__((ext_vector_type(8)));
typedef float f32x4 __attribute__((ext_vector_type(4)));
typedef unsigned u32x4 __attribute__((ext_vector_type(4)));
constexpr int BM = 256, BK = 64, HALF = 128, HTB = HALF * BK * 2  , STAGE_BYTES = 8 * HTB, NXCD = 8, WGM = 8;

__host__ __device__ __forceinline__ int lds_byte(int r, int c) { const int st = (r >> 4) * 2 + (c >> 5), rr = r & 15, cc = c & 31, ob = rr * 64 + cc * 2; return st * 1024 + (ob ^ (((ob >> 9) & 1) << 5)); }
__host__ __device__ __forceinline__ void stage_rc(int b, int& R, int& C) { const int st = b / 1024, sb = b % 1024, swz = sb ^ (((sb >> 9) & 1) << 5); R = (st >> 1) * 16 + swz / 64; C = (st & 1) * 32 + (swz % 64) / 2; }
__host__ __device__ __forceinline__ int perm32(int rho) { const int n = rho >> 4, i = rho & 15; return 8 * (i >> 2) + 4 * n + (i & 3); }

struct Unit { int pm, pn; };
struct Gemm { const bf16_t* A; const bf16_t* Bt; int M, N, K; };

struct StaticOrder {
    int nM, nN, nwg, G, c;
    __host__ __device__ void init(int M, int N, int G_, int c_) { nM = M / BM; nN = N / BM; nwg = nM * nN; G = G_; c = c_; }
    __host__ __device__ bool next(int i, Unit& u) const {
        const long L = (long)i * G + c; if (L >= nwg) return false;
        int wgid = (int)L; { const int q = nwg / NXCD, r = nwg % NXCD, xcd = wgid % NXCD, off = wgid / NXCD; wgid = (xcd < r ? xcd * (q + 1) : r * (q + 1) + (xcd - r) * q) + off; }
        const int nig = WGM * nN, gid = wgid / nig, fm = gid * WGM, gsz = (nM - fm) < WGM ? (nM - fm) : WGM;
        u.pm = fm + ((wgid % nig) % gsz); u.pn = (wgid % nig) / gsz; return true;
    }
    __device__ __forceinline__ void a_ready(const Unit&) const {}
    __device__ __forceinline__ void done(const Unit&) const {}
};

__device__ __forceinline__ unsigned cvt_pk_bf16(float lo, float hi) { unsigned r; asm volatile("v_cvt_pk_bf16_f32 %0, %1, %2" : "=v"(r) : "v"(lo), "v"(hi)); return r; }
template <class Epi, class Sched, bool ALIGN_EPI = false, bool SP2 = false>
__device__ __forceinline__ void gemm_phase(PG8_LAS unsigned char* lds, const Gemm g, const Sched& S, const Epi& E, const int tid_in) {
    int tid_ = tid_in; asm volatile("" : "+v"(tid_));
    const int tid = tid_, wid = __builtin_amdgcn_readfirstlane(tid >> 6), lane = tid & 63, wr = wid >> 2, wc = wid & 3, fr = lane & 15, fq = lane >> 4;
    int K_ = g.K; asm volatile("" : "+s"(K_));
    const int K = K_, nt = K / BK;
    unsigned voffA[2], voffB[2];
#pragma unroll
    for (int i = 0; i < 2; ++i) { int R, C; stage_rc(tid * 16 + i * 8192, R, C); const int Rb = Epi::PERM ? ((R & ~31) + perm32(R & 31)) : R;
        voffA[i] = (unsigned)(R * K + C) * 2u; voffB[i] = (unsigned)(Rb * K + C) * 2u; }
    const size_t kstep = (size_t)(BK * 2);
    const size_t hstep = (size_t)HALF * K * 2;
    const size_t tstep = 2 * hstep;
    const unsigned ldsw = (unsigned)wid * 1024u;
    const int aoff = lds_byte(wr * 64 + fr, fq * 8), boff = lds_byte(wc * 32 + fr, fq * 8);
#define PG8_SA(b, h) (((b) * 2 + (h)) * HTB)
#define PG8_SB(b, h) ((4 + (b) * 2 + (h)) * HTB)
#define PG8_STAGE(bufoff, gbase, voff) do { _Pragma("unroll") for (int _i = 0; _i < 2; ++_i) \
        __builtin_amdgcn_global_load_lds((const unsigned*)((const char*)(gbase) + (voff)[_i]), (PG8_LAS unsigned*)(lds + (bufoff) + ldsw + _i * 8192), 16, 0, 0); } while (0)
#define PG8_LDA(dst, b, h) do { _Pragma("unroll") for (int m = 0; m < 4; ++m) _Pragma("unroll") for (int k = 0; k < 2; ++k) dst[m][k] = *(const PG8_LAS bf16x8*)(lds + PG8_SA(b, h) + aoff + m * 2048 + k * 1024); } while (0)
#define PG8_LDB(dst, b, h) do { _Pragma("unroll") for (int n = 0; n < 2; ++n) _Pragma("unroll") for (int k = 0; k < 2; ++k) dst[n][k] = *(const PG8_LAS bf16x8*)(lds + PG8_SB(b, h) + boff + n * 2048 + k * 1024); } while (0)
#define PG8_MMA(ai, bj, At, Bt) do { __builtin_amdgcn_s_setprio(1); _Pragma("unroll") for (int m = 0; m < 4; ++m) _Pragma("unroll") for (int n = 0; n < 2; ++n) _Pragma("unroll") for (int k = 0; k < 2; ++k) \
        acc[ai][bj][m][n] = __builtin_amdgcn_mfma_f32_16x16x32_bf16(Bt[n][k], At[m][k], acc[ai][bj][m][n], 0, 0, 0); __builtin_amdgcn_s_setprio(0); } while (0)
#define PG8_WAIT_V(n) asm volatile("s_waitcnt vmcnt(" #n ")" ::: "memory")
#define PG8_WAIT_L(n) asm volatile("s_waitcnt lgkmcnt(" #n ")" ::: "memory")
#define PG8_BAR __builtin_amdgcn_s_barrier()
#define PG8_SCHED __builtin_amdgcn_sched_barrier(0)
    Unit cur, nxt; int ui = 0;
    if (!S.next(0, cur)) return;
    f32x4 acc[2][2][4][2];
#pragma unroll
    for (int a = 0; a < 2; ++a)
#pragma unroll
        for (int b = 0; b < 2; ++b)
#pragma unroll
            for (int m = 0; m < 4; ++m)
#pragma unroll
                for (int n = 0; n < 2; ++n) acc[a][b][m][n] = (f32x4){0.f, 0.f, 0.f, 0.f};
    bf16x8 At[4][2], B0[2][2], B1[2][2];
    const char* cA = (const char*)g.A + (size_t)cur.pm * tstep; const char* cB = (const char*)g.Bt + (size_t)cur.pn * tstep;
    S.a_ready(cur);
    if constexpr (SP2) {
        PG8_STAGE(PG8_SB(0, 0), cB, voffB); PG8_STAGE(PG8_SB(0, 1), cB + hstep, voffB); PG8_STAGE(PG8_SA(0, 0), cA, voffA); PG8_STAGE(PG8_SA(0, 1), cA + hstep, voffA);
        if (wr == 1) PG8_BAR;
        PG8_WAIT_V(2); PG8_BAR;
        PG8_STAGE(PG8_SB(1, 0), cB + kstep, voffB); PG8_STAGE(PG8_SA(1, 0), cA + kstep, voffA); PG8_STAGE(PG8_SB(1, 1), cB + hstep + kstep, voffB);
        PG8_WAIT_V(6); PG8_BAR;
    } else {
        PG8_STAGE(PG8_SB(0, 0), cB, voffB); PG8_STAGE(PG8_SA(0, 0), cA, voffA); PG8_STAGE(PG8_SB(0, 1), cB + hstep, voffB); PG8_STAGE(PG8_SA(0, 1), cA + hstep, voffA);
        if (wr == 1) PG8_BAR;
        PG8_WAIT_V(4); PG8_BAR;
        PG8_STAGE(PG8_SB(1, 0), cB + kstep, voffB); PG8_STAGE(PG8_SA(1, 0), cA + kstep, voffA); PG8_STAGE(PG8_SB(1, 1), cB + hstep + kstep, voffB);
        PG8_WAIT_V(6); PG8_BAR;
    }
    for (;;) {
        const bool has_next = S.next(ui + 1, nxt);
        const char* nA = has_next ? (const char*)g.A + (size_t)nxt.pm * tstep : cA; const char* nB = has_next ? (const char*)g.Bt + (size_t)nxt.pn * tstep : cB;
        for (int t = 0; t < nt; t += 2) {
            const bool last = (t == nt - 2);
            if constexpr (Epi::MIDSCALE) { if (t == (nt >> 1)) E.mid(acc, cur, wr, wc, fr, fq); }
            const char* a1 = cA + (size_t)(t + 1) * kstep;
            const char* a2 = last ? nA : cA + (size_t)(t + 2) * kstep; const char* b2 = last ? nB : cB + (size_t)(t + 2) * kstep;
            const char* a3 = a2 + kstep; const char* b3 = b2 + kstep;
            if (last && has_next) S.a_ready(nxt);
            if constexpr (SP2) {
            PG8_LDB(B0, 0, 0); PG8_LDB(B1, 0, 1); PG8_SCHED; PG8_LDA(At, 0, 0); PG8_STAGE(PG8_SA(1, 1), a1 + hstep, voffA);
            PG8_WAIT_V(8); PG8_WAIT_L(0); PG8_BAR; PG8_MMA(0, 0, At, B0); PG8_MMA(0, 1, At, B1); PG8_BAR; PG8_SCHED;
            PG8_LDA(At, 0, 1); PG8_STAGE(PG8_SB(0, 0), b2, voffB); PG8_STAGE(PG8_SB(0, 1), b2 + hstep, voffB); PG8_STAGE(PG8_SA(0, 0), a2, voffA);
            PG8_WAIT_V(8); PG8_WAIT_L(0); PG8_BAR; PG8_MMA(1, 0, At, B0); PG8_MMA(1, 1, At, B1); PG8_BAR; PG8_SCHED;
            PG8_LDB(B0, 1, 0); PG8_LDB(B1, 1, 1); PG8_SCHED; PG8_LDA(At, 1, 0); PG8_STAGE(PG8_SA(0, 1), a2 + hstep, voffA);
            PG8_WAIT_V(8); PG8_WAIT_L(0); PG8_BAR; PG8_MMA(0, 0, At, B0); PG8_MMA(0, 1, At, B1); PG8_BAR; PG8_SCHED;
            PG8_LDA(At, 1, 1); PG8_STAGE(PG8_SB(1, 0), b3, voffB); PG8_STAGE(PG8_SB(1, 1), b3 + hstep, voffB); PG8_STAGE(PG8_SA(1, 0), a3, voffA);
            PG8_WAIT_V(8); PG8_WAIT_L(0); PG8_BAR; PG8_MMA(1, 0, At, B0); PG8_MMA(1, 1, At, B1); PG8_BAR; PG8_SCHED;
            } else {
            PG8_LDB(B0, 0, 0); PG8_SCHED; PG8_LDA(At, 0, 0); PG8_STAGE(PG8_SA(1, 1), a1 + hstep, voffA);
            PG8_WAIT_L(8); PG8_BAR; PG8_WAIT_L(0); PG8_MMA(0, 0, At, B0); PG8_BAR; PG8_SCHED;
            PG8_LDB(B1, 0, 1); PG8_STAGE(PG8_SB(0, 0), b2, voffB);
            PG8_BAR; PG8_WAIT_L(0); PG8_MMA(0, 1, At, B1); PG8_BAR;
            PG8_LDA(At, 0, 1); PG8_STAGE(PG8_SA(0, 0), a2, voffA);
            PG8_BAR; PG8_WAIT_L(0); PG8_MMA(1, 0, At, B0); PG8_BAR; PG8_SCHED;
            PG8_STAGE(PG8_SB(0, 1), b2 + hstep, voffB);
            PG8_WAIT_V(6); PG8_BAR; PG8_MMA(1, 1, At, B1); PG8_BAR;
            PG8_LDB(B0, 1, 0); PG8_SCHED; PG8_LDA(At, 1, 0); PG8_STAGE(PG8_SA(0, 1), a2 + hstep, voffA);
            PG8_WAIT_L(8); PG8_BAR; PG8_WAIT_L(0); PG8_MMA(0, 0, At, B0); PG8_BAR; PG8_SCHED;
            PG8_LDB(B1, 1, 1); PG8_STAGE(PG8_SB(1, 0), b3, voffB);
            PG8_BAR; PG8_WAIT_L(0); PG8_MMA(0, 1, At, B1); PG8_BAR;
            PG8_LDA(At, 1, 1); PG8_STAGE(PG8_SA(1, 0), a3, voffA);
            PG8_BAR; PG8_WAIT_L(0); PG8_MMA(1, 0, At, B0); PG8_BAR; PG8_SCHED;
            PG8_STAGE(PG8_SB(1, 1), b3 + hstep, voffB);
            PG8_WAIT_V(6); PG8_BAR; PG8_MMA(1, 1, At, B1); PG8_BAR;
            }
        }
        if constexpr (ALIGN_EPI) { if (wr == 0) PG8_BAR; }
        if constexpr (!Epi::AFTER_DRAIN) { E(acc, cur, wr, wc, fr, fq); S.done(cur); }
        if (!has_next) break;
#pragma unroll
        for (int a = 0; a < 2; ++a)
#pragma unroll
            for (int b = 0; b < 2; ++b)
#pragma unroll
                for (int m = 0; m < 4; ++m)
#pragma unroll
                    for (int n = 0; n < 2; ++n) acc[a][b][m][n] = (f32x4){0.f, 0.f, 0.f, 0.f};
        cur = nxt; cA = nA; cB = nB; ++ui;
        if constexpr (ALIGN_EPI) { if (wr == 1) PG8_BAR; }
    }
    PG8_WAIT_V(0);
    if constexpr (!ALIGN_EPI) { if (wr == 0) PG8_BAR; }
    PG8_BAR;
    if constexpr (Epi::AFTER_DRAIN) { E.fused(acc, cur, wr, wc, fr, fq, lds, wid, lane); S.done(cur); }
#undef PG8_SA
#undef PG8_SB
#undef PG8_STAGE
#undef PG8_LDA
#undef PG8_LDB
#undef PG8_MMA
#undef PG8_WAIT_V
#undef PG8_WAIT_L
#undef PG8_BAR
#undef PG8_SCHED
}
}

#define XB_TMO      128
#define XB_XCNT(j)  (256  + 64 * (j))
#define XB_XSUB(j)  (1280 + 64 * (j))
#define XB_XGEN(j)  (2304 + 64 * (j))
#define XB_TOP      3328
#define XB_TOPGEN   3392
#define XCD_BAR_WORDS 3456
#define XB_SPIN_CAP (1u << 18)

__device__ __forceinline__ unsigned xb_ld(unsigned* p)              { return __hip_atomic_load(p, __ATOMIC_RELAXED, __HIP_MEMORY_SCOPE_AGENT); }
__device__ __forceinline__ unsigned xb_add(unsigned* p, unsigned v) { return __hip_atomic_fetch_add(p, v, __ATOMIC_RELAXED, __HIP_MEMORY_SCOPE_AGENT); }
__device__ __forceinline__ unsigned xb_xcc_id() { return (unsigned)__builtin_amdgcn_s_getreg((3 << 11) | 20) & 0xFu; }
#define XB_SPIN(cond, bar) do { unsigned _sp = 0; while (cond) { __builtin_amdgcn_s_sleep(1); \
    if ((++_sp & 255u) == 0u) { if (xb_ld(&(bar)[XB_TMO])) break; if (_sp > XB_SPIN_CAP) { atomicAdd(&(bar)[XB_TMO], 1u); break; } } } } while (0)

struct XcdBarrier {
    unsigned* bar; unsigned x;
    volatile LAS unsigned* st;
};

__device__ __forceinline__ XcdBarrier xcd_barrier_post(unsigned* bar, volatile LAS unsigned* st) {
    XcdBarrier b; b.bar = bar; b.x = xb_xcc_id(); b.st = st;
    if (threadIdx.x == 0) (void)xb_add(&bar[XB_XCNT(b.x)], 1u);
    return b;
}
__device__ __forceinline__ void xcd_barrier_complete(unsigned* bar, unsigned x, unsigned& nloc, unsigned& nx) {
    const unsigned G = gridDim.x * gridDim.y * gridDim.z;
    unsigned sum, cnt, mine, sp = 0u;
    for (;;) {
        sum = 0u; cnt = 0u; mine = 0u;
#pragma unroll
        for (unsigned j = 0; j < 16; ++j) { const unsigned c = xb_ld(&bar[XB_XCNT(j)]); sum += c; cnt += (c > 0u) ? 1u : 0u; mine = (j == x) ? c : mine; }
        if (sum == G) break;
        __builtin_amdgcn_s_sleep(1);
        if ((++sp & 255u) == 0u) { if (xb_ld(&bar[XB_TMO])) break; if (sp > XB_SPIN_CAP) { atomicAdd(&bar[XB_TMO], 1u); break; } }
    }
    nloc = mine > 0u ? mine : 1u; nx = cnt > 0u ? cnt : 1u;
}

__device__ __forceinline__ void xcd_barrier(const XcdBarrier& b, const bool is_t0  ) {
    asm volatile("s_waitcnt vmcnt(0)" ::: "memory");
    __syncthreads();
    if (is_t0) {
        unsigned* bar = b.bar;
        __builtin_amdgcn_s_waitcnt(0);
        unsigned nloc = b.st[0], nx = b.st[1];
        if (nloc == 0u) { xcd_barrier_complete(bar, b.x, nloc, nx); b.st[0] = nloc; b.st[1] = nx; }
        const unsigned old = xb_add(&bar[XB_XSUB(b.x)], 1u);
        const unsigned gen = old / nloc;
        if (old + 1u == (gen + 1u) * nloc) {
            __builtin_amdgcn_fence(__ATOMIC_RELEASE, "agent");
            asm volatile("s_waitcnt vmcnt(0)" ::: "memory");
            const unsigned og = xb_add(&bar[XB_TOP], 1u);
            const unsigned tg = og / nx;
            if (og + 1u == (tg + 1u) * nx) xb_add(&bar[XB_TOPGEN], 1u);
            else XB_SPIN(xb_ld(&bar[XB_TOPGEN]) == tg, bar);
            __builtin_amdgcn_fence(__ATOMIC_ACQUIRE, "agent");
            xb_add(&bar[XB_XGEN(b.x)], 1u);
            asm volatile("s_waitcnt vmcnt(0)" ::: "memory");
        } else {
            XB_SPIN(xb_ld(&bar[XB_XGEN(b.x)]) == gen, bar);
            __builtin_amdgcn_fence(__ATOMIC_ACQUIRE, "agent");
            asm volatile("s_waitcnt vmcnt(0)" ::: "memory");
        }
    }
    __syncthreads();
}


typedef unsigned short bf16;
typedef short bf16x8 __attribute__((ext_vector_type(8)));
typedef float f32x4 __attribute__((ext_vector_type(4)));
typedef unsigned u32x4 __attribute__((ext_vector_type(4)));
typedef unsigned u32x2 __attribute__((ext_vector_type(2)));
#define GAS __attribute__((address_space(1)))
#define DI __device__ __forceinline__

constexpr int BATCH = 4, SEQ = 4096, D = 1024, DEPTH = 2;
constexpr int M = BATCH * SEQ;
constexpr int NIN = 4352, FF = 4096, PLE = 256;
constexpr int NQKV = 2304, NGATE = 2048;
constexpr float EPS = 1e-6f;
constexpr float LOG2E = 1.4426950408889634f;
constexpr float C2 = 0.125f * LOG2E;
constexpr int NWAVES = 8;

constexpr size_t MiB = 1u << 20;
constexpr size_t WS_CTL = 0, CTL_ZERO_BYTES = 64 * 1024;
constexpr size_t WS_WIN = 1 * MiB;
constexpr size_t WS_WUP = WS_WIN + (size_t)NIN * D * 2;
constexpr size_t WS_WO = WS_WUP + 2 * MiB;
constexpr size_t WS_WFF1 = WS_WO + 2 * MiB;
constexpr size_t WS_WFF2 = WS_WFF1 + 8 * MiB;
constexpr size_t WS_WPE = WS_WFF2 + 8 * MiB;
constexpr size_t WS_WPG = WS_WPE + MiB / 2;
constexpr size_t WS_SS = 32 * MiB;
constexpr size_t WS_BT = 33 * MiB;
constexpr size_t WS_PB = 34 * MiB;
constexpr size_t WS_XB = 50 * MiB;
constexpr size_t WS_ATT = 82 * MiB;
constexpr size_t WS_QKV = 114 * MiB;
constexpr size_t WS_GATE = 186 * MiB;
constexpr size_t WS_MRG = WS_QKV;
constexpr size_t WS_U = WS_QKV;
constexpr size_t WS_PE = WS_ATT;
constexpr size_t WS_END = 250 * MiB;
static_assert(WS_WPG + 2 * MiB <= WS_SS && WS_U + (size_t)M * FF * 2 <= WS_END && WS_GATE + (size_t)M * NGATE * 2 <= WS_END, "ws map");
constexpr int CW_BAR = 4096;

constexpr int RING_BYTES = 131072;
constexpr int MISC_OFF = RING_BYTES + 320;
constexpr int LDS_BYTES = 147456;

DI unsigned f2bf(float f) { unsigned u = __builtin_bit_cast(unsigned, f); return (u + 0x7fffu + ((u >> 16) & 1u)) >> 16; }
DI unsigned pk2(float lo, float hi) { return f2bf(lo) | (f2bf(hi) << 16); }
typedef float f32x2_t __attribute__((ext_vector_type(2))); typedef __bf16 bf16x2_t __attribute__((ext_vector_type(2)));
DI unsigned cvtpk(float lo, float hi) { f32x2_t v = {lo, hi}; bf16x2_t b = __builtin_convertvector(v, bf16x2_t); return __builtin_bit_cast(unsigned, b); }
DI u32x4 pack8(f32x4 a, f32x4 b) { u32x4 w; w.x = cvtpk(a[0], a[1]); w.y = cvtpk(a[2], a[3]); w.z = cvtpk(b[0], b[1]); w.w = cvtpk(b[2], b[3]); return w; }
DI void unpack8(u32x4 w, f32x4& a, f32x4& b) {
    a = (f32x4){__builtin_bit_cast(float, w.x << 16), __builtin_bit_cast(float, w.x & 0xffff0000u), __builtin_bit_cast(float, w.y << 16), __builtin_bit_cast(float, w.y & 0xffff0000u)};
    b = (f32x4){__builtin_bit_cast(float, w.z << 16), __builtin_bit_cast(float, w.z & 0xffff0000u), __builtin_bit_cast(float, w.w << 16), __builtin_bit_cast(float, w.w & 0xffff0000u)}; }
template <int X> DI float swz_xor(float v) { return __builtin_bit_cast(float, __builtin_amdgcn_ds_swizzle(__builtin_bit_cast(int, v), (X << 10) | 0x1f)); }
DI float sum_halves(float v) { auto rr = __builtin_amdgcn_permlane32_swap(__float_as_uint(v), __float_as_uint(v), false, false); return __uint_as_float(rr[0]) + __uint_as_float(rr[1]); }
DI float wave_sum(float v) { v += swz_xor<1>(v); v += swz_xor<2>(v); v += swz_xor<4>(v); v += swz_xor<8>(v); v += swz_xor<16>(v); return sum_halves(v); }
DI float rs_from(f32x4 s) { return 1.0f / sqrtf(((s[0] + s[1]) + (s[2] + s[3])) * (1.0f / D) + EPS); }
DI float sigm(float v) { return 1.0f / (1.0f + __expf(-v)); }
#define MEMFENCE() asm volatile("" ::: "memory")

using pg8::Unit;
constexpr int HALF = 128;
DI void load_rs8(const float* SS, int row0, float (&rs)[2][4]) {
    f32x4 s[2][4];
#pragma unroll
    for (int ai = 0; ai < 2; ++ai)
#pragma unroll
        for (int m = 0; m < 4; ++m) s[ai][m] = *(const f32x4*)(SS + (size_t)(row0 + ai * HALF + m * 16) * 4);
#pragma unroll
    for (int ai = 0; ai < 2; ++ai)
#pragma unroll
        for (int m = 0; m < 4; ++m) rs[ai][m] = rs_from(s[ai][m]);
}

struct EpiIn {
    static constexpr bool PERM = true, AFTER_DRAIN = false, MIDSCALE = false;
    const float* SS; bf16* QKV; bf16* GATE;
    DI void operator()(const f32x4 (&acc)[2][2][4][2], const Unit& u, int wr, int wc, int fr, int fq) const {
        const int row0 = u.pm * 256 + wr * 64 + fr;
        float rs[2][4]; load_rs8(SS, row0, rs);
        if (u.pn < 9) {
            const float cs = (u.pn < 2 || u.pn == 6 || u.pn == 7) ? C2 : 1.0f;
            const int col0 = u.pn * 256 + wc * 32 + 8 * fq;
#pragma unroll
            for (int ai = 0; ai < 2; ++ai)
#pragma unroll
                for (int m = 0; m < 4; ++m) { const float sc = rs[ai][m] * cs; bf16* rowp = QKV + (size_t)(row0 + ai * HALF + m * 16) * NQKV + col0;
#pragma unroll
                    for (int bj = 0; bj < 2; ++bj) *(u32x4*)(rowp + bj * HALF) = pack8(acc[ai][bj][m][0] * sc, acc[ai][bj][m][1] * sc); }
        } else {
            const int c0 = (u.pn - 9) * 128 + wc * 32 + 8 * fq;
#pragma unroll
            for (int ai = 0; ai < 2; ++ai)
#pragma unroll
                for (int m = 0; m < 4; ++m) { const float r = rs[ai][m]; bf16* rowp = GATE + (size_t)(row0 + ai * HALF + m * 16) * NGATE + c0;
                    f32x4 ra[2], gb[2];
#pragma unroll
                    for (int n = 0; n < 2; ++n)
#pragma unroll
                        for (int j = 0; j < 4; ++j) { const float ea = fminf(__expf(-acc[ai][0][m][n][j] * r), 1e30f), eb = fminf(__expf(-acc[ai][1][m][n][j] * r), 1e30f);
                            const float g = 1.0f / (1.0f + eb); gb[n][j] = g; ra[n][j] = (1.0f + eb) / (1.0f + ea); }
                    *(u32x4*)rowp = pack8(ra[0], ra[1]); *(u32x4*)(rowp + 1024) = pack8(gb[0], gb[1]); }
        }
    }
};
struct EpiUp {
    static constexpr bool PERM = true, AFTER_DRAIN = false, MIDSCALE = true;
    const bf16* GATE; bf16* MRG;
    DI void mid(f32x4 (&acc)[2][2][4][2], const Unit& u, int wr, int wc, int fr, int fq) const {
        const int row0 = u.pm * 256 + wr * 64 + fr, col0 = u.pn * 256 + wc * 32 + 8 * fq;
#pragma unroll
        for (int ai = 0; ai < 2; ++ai)
#pragma unroll
            for (int m = 0; m < 4; ++m) { const bf16* rowp = GATE + (size_t)(row0 + ai * HALF + m * 16) * NGATE + col0;
#pragma unroll
                for (int bj = 0; bj < 2; ++bj) { f32x4 a, b; unpack8(*(const u32x4*)(rowp + bj * HALF), a, b); acc[ai][bj][m][0] *= a; acc[ai][bj][m][1] *= b; }
                MEMFENCE(); }
    }
    DI void operator()(const f32x4 (&acc)[2][2][4][2], const Unit& u, int wr, int wc, int fr, int fq) const {
        const int row0 = u.pm * 256 + wr * 64 + fr, col0 = u.pn * 256 + wc * 32 + 8 * fq;
#pragma unroll
        for (int ai = 0; ai < 2; ++ai)
#pragma unroll
            for (int m = 0; m < 4; ++m) { const size_t r = (size_t)(row0 + ai * HALF + m * 16);
#pragma unroll
                for (int bj = 0; bj < 2; ++bj) { f32x4 a, b; unpack8(*(const u32x4*)(GATE + r * NGATE + 1024 + col0 + bj * HALF), a, b);
                    *(u32x4*)(MRG + r * D + col0 + bj * HALF) = pack8(acc[ai][bj][m][0] * a, acc[ai][bj][m][1] * b); }
                if (m & 1) MEMFENCE(); }
    }
};
struct EpiFf1 {
    static constexpr bool PERM = true, AFTER_DRAIN = false, MIDSCALE = false;
    const float* SS; bf16* U;
    DI void operator()(const f32x4 (&acc)[2][2][4][2], const Unit& u, int wr, int wc, int fr, int fq) const {
        const int row0 = u.pm * 256 + wr * 64 + fr, col0 = u.pn * 256 + wc * 32 + 8 * fq;
        float rs[2][4]; load_rs8(SS, row0, rs);
#pragma unroll
        for (int ai = 0; ai < 2; ++ai)
#pragma unroll
            for (int m = 0; m < 4; ++m) { const float r = rs[ai][m]; bf16* rowp = U + (size_t)(row0 + ai * HALF + m * 16) * FF + col0;
#pragma unroll
                for (int bj = 0; bj < 2; ++bj) { f32x4 v0 = acc[ai][bj][m][0] * r, v1 = acc[ai][bj][m][1] * r;
#pragma unroll
                    for (int j = 0; j < 4; ++j) { const float a = fmaxf(v0[j], 0.f), b = fmaxf(v1[j], 0.f); v0[j] = a * a; v1[j] = b * b; }
                    *(u32x4*)(rowp + bj * HALF) = pack8(v0, v1); } }
    }
};
struct EpiPe {
    static constexpr bool PERM = true, AFTER_DRAIN = false, MIDSCALE = false;
    bf16* PE;
    DI void operator()(const f32x4 (&acc)[2][2][4][2], const Unit& u, int wr, int wc, int fr, int fq) const {
        const int row0 = u.pm * 256 + wr * 64 + fr, col0 = u.pn * 256 + wc * 32 + 8 * fq;
#pragma unroll
        for (int ai = 0; ai < 2; ++ai)
#pragma unroll
            for (int m = 0; m < 4; ++m) { bf16* rowp = PE + (size_t)(row0 + ai * HALF + m * 16) * D + col0;
#pragma unroll
                for (int bj = 0; bj < 2; ++bj) *(u32x4*)(rowp + bj * HALF) = pack8(acc[ai][bj][m][0], acc[ai][bj][m][1]); }
    }
};
template <bool GATED, bool XF32> struct EpiRes {
    static constexpr bool PERM = true, AFTER_DRAIN = true, MIDSCALE = false;
    const float* xin32; const bf16* xin16; bf16* XBout; float* SS; const bf16* PE; const float* SSr; bool dry; XcdBarrier bar;
    DI void fused(f32x4 (&acc)[2][2][4][2], const Unit& u, int wr, int wc, int fr, int fq, LAS unsigned char* lds, int wid, int lane) const {
        const int row0 = u.pm * 256 + wr * 64 + fr, col0 = u.pn * 256 + wc * 32 + 8 * fq;
        LAS float* P = (LAS float*)lds;
        float rs[2][4];
        if (GATED) { load_rs8(SSr, row0, rs); xcd_barrier(bar, wid == 0 && lane == 0); }
#pragma unroll
        for (int ai = 0; ai < 2; ++ai)
#pragma unroll
            for (int m = 0; m < 4; ++m) { const size_t r = (size_t)(row0 + ai * HALF + m * 16); float ss = 0.f;
#pragma unroll
                for (int bj = 0; bj < 2; ++bj) { const size_t o = r * D + col0 + bj * HALF;
                    f32x4 x0, x1, v0 = acc[ai][bj][m][0], v1 = acc[ai][bj][m][1];
                    if (XF32) { x0 = *(const f32x4*)(xin32 + o); x1 = *(const f32x4*)(xin32 + o + 4); } else unpack8(*(const u32x4*)(xin16 + o), x0, x1);
                    if (GATED) { f32x4 p0, p1; unpack8(*(const u32x4*)(PE + o), p0, p1); const float rr = rs[ai][m];
#pragma unroll
                        for (int j = 0; j < 4; ++j) { v0[j] = p0[j] * sigm(v0[j] * rr); v1[j] = p1[j] * sigm(v1[j] * rr); } }
                    x0 += v0; x1 += v1;
                    if (!dry) *(u32x4*)(XBout + o) = pack8(x0, x1);
                    ss += ((x0[0] * x0[0] + x0[1] * x0[1]) + (x0[2] * x0[2] + x0[3] * x0[3])) + ((x1[0] * x1[0] + x1[1] * x1[1]) + (x1[2] * x1[2] + x1[3] * x1[3])); }
                ss += swz_xor<16>(ss); ss = sum_halves(ss);
                if (fq == 0) P[(ai * HALF + wr * 64 + m * 16 + fr) * 4 + wc] = ss;
                if (m & 1) MEMFENCE(); }
        __syncthreads();
        if (wid < 4 && !dry) { const int row = wid * 64 + lane; const f32x4 p = *(const LAS f32x4*)(P + row * 4);
            SS[(size_t)(u.pm * 256 + row) * 4 + u.pn] = (p[0] + p[1]) + (p[2] + p[3]); }
        __syncthreads();
    }
};


namespace att {
typedef short s16x4 __attribute__((ext_vector_type(4)));
typedef float f32x16 __attribute__((ext_vector_type(16)));
typedef LAS const char* lds_cptr;
#define SBAR() __builtin_amdgcn_sched_barrier(0)
#define MFMA32(a, b, c) __builtin_amdgcn_mfma_f32_32x32x16_bf16((a), (b), (c), 0, 0, 0)
DI int crow(int r, int hi) { return (r & 3) + 8 * (r >> 2) + 4 * hi; }
DI void qkt(f32x16& p0, f32x16& p1, lds_cptr Kslot, const bf16x8* qr, int r32, int hi) {
    const lds_cptr kb = Kslot + hi * 1024 + r32 * 16;
    f32x16 z0 = {}, z1 = {};
#pragma unroll
    for (int d0 = 0; d0 < 4; ++d0) {
        const bf16x8 b0 = *(const LAS bf16x8*)(kb + d0 * 2048), b1 = *(const LAS bf16x8*)(kb + d0 * 2048 + 512);
        z0 = MFMA32(b0, qr[d0], z0); z1 = MFMA32(b1, qr[d0], z1); }
    p0 = z0; p1 = z1;
}
DI void pv(f32x16* o, int vb, bf16x8 pa0, bf16x8 pa1, bf16x8 pa2, bf16x8 pa3) {
#pragma unroll
    for (int d0 = 0; d0 < 2; ++d0) { s16x4 lo[4], hi[4];
#pragma unroll
        for (int ks = 0; ks < 4; ++ks) {
            asm volatile("ds_read_b64_tr_b16 %0,%1 offset:%c2" : "=&v"(lo[ks]) : "v"(vb), "i"(d0 * 4096 + ks * 1024) : "memory");
            asm volatile("ds_read_b64_tr_b16 %0,%1 offset:%c2" : "=&v"(hi[ks]) : "v"(vb), "i"(d0 * 4096 + ks * 1024 + 512) : "memory"); }
        asm volatile("s_waitcnt lgkmcnt(0)" ::: "memory"); SBAR();
#define PK(k) (bf16x8){lo[k][0], lo[k][1], lo[k][2], lo[k][3], hi[k][0], hi[k][1], hi[k][2], hi[k][3]}
        o[d0] = MFMA32(pa0, PK(0), o[d0]); o[d0] = MFMA32(pa1, PK(1), o[d0]); o[d0] = MFMA32(pa2, PK(2), o[d0]); o[d0] = MFMA32(pa3, PK(3), o[d0]);
#undef PK
    }
}
DI int vlane_ofs(int lane, int hi) { return ((lane >> 4) & 1) * 32 + (lane & 3) * 8 + (4 * hi + ((lane & 15) >> 2)) * 64; }
DI float other_half(float v, int hi) { auto rr = __builtin_amdgcn_permlane32_swap(__float_as_uint(v), __float_as_uint(v), false, false); return __uint_as_float(hi ? rr[0] : rr[1]); }
DI void pack_p(const f32x16& p0, const f32x16& p1, u32x4& w0, u32x4& w1, u32x4& w2, u32x4& w3) {
    w0 = (u32x4){cvtpk(p0[0], p0[1]), cvtpk(p0[2], p0[3]), cvtpk(p0[4], p0[5]), cvtpk(p0[6], p0[7])};
    w1 = (u32x4){cvtpk(p0[8], p0[9]), cvtpk(p0[10], p0[11]), cvtpk(p0[12], p0[13]), cvtpk(p0[14], p0[15])};
    w2 = (u32x4){cvtpk(p1[0], p1[1]), cvtpk(p1[2], p1[3]), cvtpk(p1[4], p1[5]), cvtpk(p1[6], p1[7])};
    w3 = (u32x4){cvtpk(p1[8], p1[9]), cvtpk(p1[10], p1[11]), cvtpk(p1[12], p1[13]), cvtpk(p1[14], p1[15])};
}
DI void store_o(const f32x16* o, const float* scale, LAS bf16* stg, bf16* Ow, int pitch, int lane, int r32, int hi) {
#pragma unroll
    for (int r = 0; r < 16; ++r) { const int orow = crow(r, hi); const float sc = scale ? scale[r] : 1.0f;
#pragma unroll
        for (int d0 = 0; d0 < 2; ++d0) stg[orow * 64 + d0 * 32 + r32] = (bf16)f2bf(o[d0][r] * sc); }
    asm volatile("s_waitcnt lgkmcnt(0)" ::: "memory");
#pragma unroll
    for (int i = 0; i < 4; ++i) { const int row = i * 8 + (lane >> 3), ch = lane & 7; const u32x4 v = *(const LAS u32x4*)(stg + row * 64 + ch * 8); *(u32x4*)(Ow + (long)row * pitch + ch * 8) = v; }
}

DI void sb_half(f32x16& p, float& T, int kb, int qabs, bool need_mask, int hi) {
    f32x16 bt;
#pragma unroll
    for (int r = 0; r < 16; ++r) { const float e = __builtin_fminf(__builtin_amdgcn_exp2f(-p[r]), 1.8446744e19f), b = __builtin_amdgcn_rcpf(1.0f + e); bt[r] = b; p[r] = e * b; }
    if (need_mask) {
#pragma unroll
        for (int r = 0; r < 16; ++r) { const int key = kb + (r & 3) + 8 * (r >> 2); if (key >= qabs) { p[r] = 1.0f; bt[r] = 0.f; } } }
    float gp[4], og[4];
#pragma unroll
    for (int g = 0; g < 4; ++g) gp[g] = (p[4 * g] * p[4 * g + 1]) * (p[4 * g + 2] * p[4 * g + 3]);
#pragma unroll
    for (int g = 0; g < 4; ++g) og[g] = other_half(gp[g], hi);
#pragma unroll
    for (int g = 3; g >= 0; --g) { float S = T * (hi ? 1.0f : og[g]); T *= gp[g] * og[g];
        const float a3 = bt[4 * g + 3] * S; S *= p[4 * g + 3];
        const float a2 = bt[4 * g + 2] * S; S *= p[4 * g + 2];
        const float a1 = bt[4 * g + 1] * S; S *= p[4 * g + 1];
        const float a0 = bt[4 * g] * S;
        p[4 * g] = a0; p[4 * g + 1] = a1; p[4 * g + 2] = a2; p[4 * g + 3] = a3; }
}
DI void load_k(bf16x8 (&kf)[8], const bf16* ksrc, int jt) {
    const bf16* p = ksrc + (long)jt * 64 * NQKV;
#pragma unroll
    for (int d0 = 0; d0 < 4; ++d0) { kf[2 * d0] = *(const bf16x8*)(p + 16 * d0); kf[2 * d0 + 1] = *(const bf16x8*)(p + (long)32 * NQKV + 16 * d0); }
}
DI void dma_v(const bf16* vsrc, int jt, LAS char* slot) {
    const bf16* p = vsrc + (long)jt * 64 * NQKV;
#pragma unroll
    for (int i = 0; i < 8; ++i) __builtin_amdgcn_global_load_lds((const GAS unsigned*)(p + (long)(16 * (i & 3)) * NQKV + 32 * (i >> 2)), (LAS unsigned*)(slot + i * 1024), 16, 0, 0);
}
DI void load_v(u32x4 (&vr)[8], const bf16* vsrc, int jt) {
    const bf16* p = vsrc + (long)jt * 64 * NQKV;
#pragma unroll
    for (int i = 0; i < 8; ++i) vr[i] = *(const u32x4*)(p + (long)(16 * (i & 3)) * NQKV + 32 * (i >> 2));
}
DI void store_v(const u32x4 (&vr)[8], LAS char* slot, int lane) {
#pragma unroll
    for (int i = 0; i < 8; ++i) *(LAS u32x4*)(slot + i * 1024 + lane * 16) = vr[i];
}
template <int KB> DI f32x16 qkt_h(const bf16x8 (&kf)[8], const bf16x8* qr) {
    f32x16 z = {};
#pragma unroll
    for (int d0 = 0; d0 < 4; ++d0) z = MFMA32(kf[2 * d0 + KB], qr[d0], z);
    return z;
}
template <int KB> DI void pv_h(f32x16* o, int vb, const f32x16& p) {
    const u32x4 w0 = (u32x4){cvtpk(p[0], p[1]), cvtpk(p[2], p[3]), cvtpk(p[4], p[5]), cvtpk(p[6], p[7])}, w1 = (u32x4){cvtpk(p[8], p[9]), cvtpk(p[10], p[11]), cvtpk(p[12], p[13]), cvtpk(p[14], p[15])};
    s16x4 lo[4], hi[4];
#pragma unroll
    for (int d0 = 0; d0 < 2; ++d0)
#pragma unroll
        for (int ks = 0; ks < 2; ++ks) {
            asm volatile("ds_read_b64_tr_b16 %0,%1 offset:%c2" : "=&v"(lo[2 * d0 + ks]) : "v"(vb), "i"(d0 * 4096 + (2 * KB + ks) * 1024) : "memory");
            asm volatile("ds_read_b64_tr_b16 %0,%1 offset:%c2" : "=&v"(hi[2 * d0 + ks]) : "v"(vb), "i"(d0 * 4096 + (2 * KB + ks) * 1024 + 512) : "memory"); }
    asm volatile("s_waitcnt lgkmcnt(0)" ::: "memory"); SBAR();
#define PK(k) (bf16x8){lo[k][0], lo[k][1], lo[k][2], lo[k][3], hi[k][0], hi[k][1], hi[k][2], hi[k][3]}
    o[0] = MFMA32(__builtin_bit_cast(bf16x8, w0), PK(0), o[0]); o[0] = MFMA32(__builtin_bit_cast(bf16x8, w1), PK(1), o[0]);
    o[1] = MFMA32(__builtin_bit_cast(bf16x8, w0), PK(2), o[1]); o[1] = MFMA32(__builtin_bit_cast(bf16x8, w1), PK(3), o[1]);
#undef PK
}
DI void load_rows(u32x4 (&r)[8], const bf16* src, int jt) {
    const bf16* p = src + (long)jt * 64 * NQKV;
#pragma unroll
    for (int i = 0; i < 8; ++i) r[i] = *(const u32x4*)(p + (long)(8 * i) * NQKV);
}
DI void store_k_img(const u32x4 (&r)[8], LAS char* img, int lane) {
#pragma unroll
    for (int i = 0; i < 8; ++i) *(LAS u32x4*)(img + (lane & 7) * 1024 + (8 * i + (lane >> 3)) * 16) = r[i];
}
DI void store_v_img(const u32x4 (&r)[8], LAS char* img, int lane) {
#pragma unroll
    for (int i = 0; i < 8; ++i) { const int key = 8 * i + (lane >> 3), c = lane & 7; *(LAS u32x4*)(img + (c >> 2) * 4096 + (key >> 4) * 1024 + (key & 15) * 64 + (c & 3) * 16) = r[i]; }
}
template <int KB> DI f32x16 qkt_l(lds_cptr kimg, const bf16x8* qr, int r32, int hi) {
    const lds_cptr kb = kimg + hi * 1024 + KB * 512 + r32 * 16;
    f32x16 z = {};
#pragma unroll
    for (int d0 = 0; d0 < 4; ++d0) z = MFMA32(*(const LAS bf16x8*)(kb + d0 * 2048), qr[d0], z);
    return z;
}
template <bool EARLY> DI void sbw_unit(int b, int h, int qb32, const bf16* QKV, bf16* ATT, LAS char* wl, int lane) {
    const int r32 = lane & 31, hi = lane >> 5;
    const long rowbase = (long)b * SEQ; const int qs = qb32 * 32, qabs = qs + r32;
    const bf16* Qw = QKV + (rowbase + qs) * NQKV + h * 64;
    const bf16* ksrc = QKV + rowbase * NQKV + 512 + h * 64 + (long)(lane >> 3) * NQKV + (lane & 7) * 8;
    const bf16* vsrc = ksrc + 512;
    bf16x8 qr[4];
#pragma unroll
    for (int d0 = 0; d0 < 4; ++d0) qr[d0] = *(const bf16x8*)(Qw + (long)r32 * NQKV + d0 * 16 + hi * 8);
    f32x16 o[2]; o[0] = f32x16{}; o[1] = f32x16{};
    float T = 1.0f;
    int jt = (qs + 31) >> 6;
    LAS char* kimg = wl; LAS char* vimg = wl + 8192;
    const int vofs = (int)(uintptr_t)vimg + vlane_ofs(lane, hi);
    bool skip_hi = (qs & 32) == 0;
    u32x4 kr[8], vr[8];
    load_rows(kr, ksrc, jt); load_rows(vr, vsrc, jt);
    for (;;) {
        store_k_img(kr, kimg, lane); store_v_img(vr, vimg, lane);
        if (jt > 0) { load_rows(kr, ksrc, jt - 1); load_rows(vr, vsrc, jt - 1); }
        f32x16 p1, p0;
        if (!skip_hi) p1 = qkt_l<1>((lds_cptr)kimg, qr, r32, hi);
        p0 = qkt_l<0>((lds_cptr)kimg, qr, r32, hi);
        bool done = false;
        if (!skip_hi) { sb_half(p1, T, 64 * jt + 32 + 4 * hi, qabs, 64 * jt + 63 >= qs, hi);
            pv_h<1>(o, vofs, p1);
            if (EARLY) done = __all(T == 0.0f) != 0; }
        if (!done) { sb_half(p0, T, 64 * jt + 4 * hi, qabs, 64 * jt + 31 >= qs, hi);
            pv_h<0>(o, vofs, p0);
            if (EARLY) done = __all(T == 0.0f) != 0; }
        if (done || jt == 0) break;
        skip_hi = false; --jt;
    }
    asm volatile("s_waitcnt lgkmcnt(0)" ::: "memory");
    store_o(o, nullptr, (LAS bf16*)wl, ATT + (rowbase + qs) * D + h * 64, D, lane, r32, hi);
    asm volatile("s_waitcnt lgkmcnt(0)" ::: "memory");
}

template <int KB> DI void swa_scores(f32x16& s, const bf16x8 (&kf)[8], const bf16x8* qr, const LAS float* btl, int db  , float& m) {
    s = qkt_h<KB>(kf, qr);
#pragma unroll
    for (int r = 0; r < 16; ++r) { const int d_ = db - ((r & 3) + 8 * (r >> 2)); const float v = s[r] + btl[d_ & 127]; s[r] = (unsigned)d_ < 128u ? v : -INFINITY; m = __builtin_fmaxf(m, s[r]); }
}
template <int KB> DI void swa_pv(f32x16& s, float m, float& l, f32x16* o, int vb) {
#pragma unroll
    for (int r = 0; r < 16; ++r) { s[r] = __builtin_amdgcn_exp2f(s[r] - m); l += s[r]; }
    pv_h<KB>(o, vb, s);
}
DI void swaw_unit(int b, int h, int qb32, int layer, const bf16* QKV, const float* BT, bf16* ATT, LAS char* wl, LAS float* btl, LAS float* wsf, int lane) {
    const int r32 = lane & 31, hi = lane >> 5, kvh = h >> 2;
    const long rowbase = (long)b * SEQ; const int qs = qb32 * 32, qabs = qs + r32;
    const bf16* Qw = QKV + (rowbase + qs) * NQKV + 1536 + h * 64;
    const bf16* ksrc = QKV + rowbase * NQKV + 2048 + kvh * 64 + (long)r32 * NQKV + hi * 8;
    const bf16* vsrc = QKV + rowbase * NQKV + 2176 + kvh * 64 + (long)(lane >> 2) * NQKV + (lane & 3) * 8;
    const int jlo = (qs - 127) >> 6;
    const bool odd = (qs & 32) != 0;
    const bool t0 = jlo >= 0, t1 = jlo + 1 >= 0;
    bf16x8 kA[8], kB[8];
    if (t0) load_k(kA, ksrc, jlo);
    if (t1) load_k(kB, ksrc, jlo + 1);
    if (t0) dma_v(vsrc, jlo, wl);
    if (t1) dma_v(vsrc, jlo + 1, wl + 8192);
    btl[lane] = BT[h * 128 + lane]; btl[64 + lane] = BT[h * 128 + 64 + lane];
    const float sink = BT[1024 + layer * 8 + h];
    bf16x8 qr[4];
#pragma unroll
    for (int d0 = 0; d0 < 4; ++d0) qr[d0] = *(const bf16x8*)(Qw + (long)r32 * NQKV + d0 * 16 + hi * 8);
    const int vofs = (int)(uintptr_t)wl + vlane_ofs(lane, hi);
    asm volatile("s_waitcnt lgkmcnt(0)" ::: "memory");
    const int db0 = qabs - (64 * jlo + 4 * hi);
    f32x16 s00, s01, s10, s11, s20, s21;
    float m = sink;
    if (t0) { if (!odd) swa_scores<0>(s00, kA, qr, btl, db0, m); swa_scores<1>(s01, kA, qr, btl, db0 - 32, m); }
    load_k(kA, ksrc, jlo + 2);
    if (t1) { swa_scores<0>(s10, kB, qr, btl, db0 - 64, m); swa_scores<1>(s11, kB, qr, btl, db0 - 96, m); }
    swa_scores<0>(s20, kA, qr, btl, db0 - 128, m); if (odd) swa_scores<1>(s21, kA, qr, btl, db0 - 160, m);
    m = __builtin_fmaxf(m, other_half(m, hi));
    f32x16 o[2]; o[0] = f32x16{}; o[1] = f32x16{};
    float l = 0.f;
    asm volatile("s_waitcnt vmcnt(0)" ::: "memory");
    if (t0) { if (!odd) swa_pv<0>(s00, m, l, o, vofs); swa_pv<1>(s01, m, l, o, vofs); }
    dma_v(vsrc, jlo + 2, wl);
    if (t1) { swa_pv<0>(s10, m, l, o, vofs + 8192); swa_pv<1>(s11, m, l, o, vofs + 8192); }
    asm volatile("s_waitcnt vmcnt(0)" ::: "memory");
    swa_pv<0>(s20, m, l, o, vofs); if (odd) swa_pv<1>(s21, m, l, o, vofs);
    l += other_half(l, hi); l += __builtin_amdgcn_exp2f(sink - m);
    if (hi == 0) wsf[r32] = 1.0f / l;
    asm volatile("s_waitcnt lgkmcnt(0)" ::: "memory");
    float rli[16];
#pragma unroll
    for (int r = 0; r < 16; ++r) rli[r] = wsf[crow(r, hi)];
    store_o(o, rli, (LAS bf16*)wl, ATT + (rowbase + qs) * D + 512 + h * 64, D, lane, r32, hi);
    asm volatile("s_waitcnt lgkmcnt(0)" ::: "memory");
}
#undef SBAR
#undef MFMA32
}


DI void conv_w(const float* W, const float* g, bf16* WT, int K, int N, int ldk, int koff, bool perm_gate, LAS float* scr, int gw, int NGW, int lane) {
    const int nblk = N / 32, nitems = (K / 64) * nblk;
    float cur[32], nxt[32]; f32x4 gc0, gc1, gn0, gn1;
#define CONV_LOAD(dst, g0_, g1_, it) do { const int kb_ = (it) / nblk, nb_ = (it) % nblk; const float* wp_ = W + (size_t)(64 * kb_ + (lane >> 5)) * N + 32 * nb_ + (lane & 31); \
        _Pragma("unroll") for (int i = 0; i < 32; ++i) dst[i] = wp_[(size_t)(2 * i) * N]; \
        g0_ = *(const f32x4*)(g + 64 * kb_ + 8 * (lane & 7)); g1_ = *(const f32x4*)(g + 64 * kb_ + 8 * (lane & 7) + 4); } while (0)
    int item = gw;
    if (item < nitems) CONV_LOAD(cur, gc0, gc1, item);
    while (item < nitems) {
        const int next = item + NGW;
        if (next < nitems) CONV_LOAD(nxt, gn0, gn1, next);
        const int kb = item / nblk, nb = item % nblk, k0 = 64 * kb, n0 = 32 * nb;
        int nd = n0;
        if (perm_gate && n0 >= NQKV) { const int c = n0 - NQKV; nd = c < 1024 ? NQKV + 256 * (c >> 7) + (c & 127) : NQKV + 256 * ((c - 1024) >> 7) + 128 + ((c - 1024) & 127); }
#pragma unroll
        for (int i = 0; i < 32; ++i) scr[(2 * i + (lane >> 5)) * 33 + (lane & 31)] = cur[i];
        asm volatile("s_waitcnt lgkmcnt(0)" ::: "memory");
        const int c = lane & 7;
#pragma unroll
        for (int j = 0; j < 4; ++j) { const int n = (lane >> 3) + 8 * j; const LAS float* s = scr + (8 * c) * 33 + n;
            u32x4 o; o.x = cvtpk(s[0 * 33] * gc0[0], s[1 * 33] * gc0[1]); o.y = cvtpk(s[2 * 33] * gc0[2], s[3 * 33] * gc0[3]); o.z = cvtpk(s[4 * 33] * gc1[0], s[5 * 33] * gc1[1]); o.w = cvtpk(s[6 * 33] * gc1[2], s[7 * 33] * gc1[3]);
            *(u32x4*)(WT + (size_t)(nd + n) * ldk + koff + k0 + 8 * c) = o; }
        asm volatile("s_waitcnt lgkmcnt(0)" ::: "memory");
#pragma unroll
        for (int i = 0; i < 32; ++i) cur[i] = nxt[i];
        gc0 = gn0; gc1 = gn1;
        item = next;
    }
#undef CONV_LOAD
}
DI void rownorm_rows(const float* x, bf16* XB, float* SS, int gw, int NGW, int lane) {
    for (int row = gw; row < M; row += 2 * NGW) {
        const int row2 = row + NGW < M ? row + NGW : row;
        const f32x4* xa = (const f32x4*)(x + (size_t)row * D) + lane; const f32x4* xb = (const f32x4*)(x + (size_t)row2 * D) + lane;
        f32x4 va[4], vb[4];
#pragma unroll
        for (int j = 0; j < 4; ++j) { va[j] = xa[64 * j]; vb[j] = xb[64 * j]; }
        u32x2* oa = (u32x2*)(XB + (size_t)row * D) + lane; u32x2* ob = (u32x2*)(XB + (size_t)row2 * D) + lane;
        float sa = 0.f, sb = 0.f;
#pragma unroll
        for (int j = 0; j < 4; ++j) { const f32x4 v = va[j], w = vb[j];
            sa += (v[0] * v[0] + v[1] * v[1]) + (v[2] * v[2] + v[3] * v[3]); sb += (w[0] * w[0] + w[1] * w[1]) + (w[2] * w[2] + w[3] * w[3]);
            u32x2 p; p.x = cvtpk(v[0], v[1]); p.y = cvtpk(v[2], v[3]); oa[64 * j] = p; u32x2 q; q.x = cvtpk(w[0], w[1]); q.y = cvtpk(w[2], w[3]); ob[64 * j] = q; }
        sa = wave_sum(sa); sb = wave_sum(sb);
        if (lane == 0) { *(f32x4*)(SS + (size_t)row * 4) = (f32x4){sa, 0.f, 0.f, 0.f}; *(f32x4*)(SS + (size_t)row2 * 4) = (f32x4){sb, 0.f, 0.f, 0.f}; }
    }
}
DI void final_rows(const bf16* xb, float* out, const float* SS, const float* gf, int gw, int NGW, int lane, bool dry) {
    for (int row = gw; row < M; row += NGW) {
        const u32x4* xr = (const u32x4*)(xb + (size_t)row * D) + lane; f32x4* orow = (f32x4*)(out + (size_t)row * D) + 2 * lane; const f32x4* g4 = (const f32x4*)gf + 2 * lane;
        const float r = rs_from(*(const f32x4*)(SS + (size_t)row * 4));
#pragma unroll
        for (int j = 0; j < 2; ++j) { f32x4 a, b; unpack8(xr[64 * j], a, b); a = (a * r) * g4[128 * j]; b = (b * r) * g4[128 * j + 1];
            if (!dry) { orow[128 * j] = a; orow[128 * j + 1] = b; } else asm volatile("" :: "v"(a), "v"(b)); }
    }
}
DI int t5_bucket(int d) {
    if (d < 16) return d;
    const int large = 16 + (int)(logf((float)d / 16.0f) / 2.0794415416798357f * 16.0f);
    return large < 31 ? large : 31;
}

#ifndef PROBE_TS
#define PROBE_TS -1
#endif
#ifndef MK_N_LAUNCHES
#define MK_N_LAUNCHES 1
#endif
constexpr int NPH = 16;
struct Args { const float* in[16]; float* out; unsigned char* ws; int ph_lo, ph_hi; };
static_assert(sizeof(Args) == 16 * 8 + 8 + 8 + 8, "Args has no padding");

typedef const __attribute__((address_space(4))) Args* KArgs;
struct PeOrder {
    int nM, nN, nwg, G, c, skip;
    DI void init(int M_, int N_, int G_, int c_, int skip_) { nM = M_ / 256; nN = N_ / 256; nwg = nM * nN; G = G_; c = c_; skip = skip_ < G_ ? skip_ : 0; }
    DI bool next(int i, pg8::Unit& u) const { if (c < skip) return false; const int L = i * (G - skip) + (c - skip); if (L >= nwg) return false; u.pm = L / nN; u.pn = L % nN; return true; }
    DI void a_ready(const pg8::Unit&) const {}
    DI void done(const pg8::Unit&) const {}
};
DI KArgs kargs() { KArgs p = (KArgs)__builtin_amdgcn_kernarg_segment_ptr(); asm volatile("" : "+s"(p)); return p; }
struct Ctx { int tid, lane, wave, G, bx, vcu, gw, NGW; };
DI Ctx ctx(int wv) { Ctx c; int z = 0; asm volatile("" : "+v"(z)); const int ln = __builtin_amdgcn_mbcnt_hi(~0u, __builtin_amdgcn_mbcnt_lo(~0u, z)); int t = wv * 64 + ln; asm volatile("" : "+v"(t));
    int b = blockIdx.x; asm volatile("" : "+s"(b)); c.tid = t; c.lane = ln; c.wave = wv;
    c.G = gridDim.x; c.bx = b; c.vcu = (c.G % 8 == 0) ? (b % 8) * (c.G / 8) + b / 8 : b; c.gw = c.vcu * NWAVES + c.wave; c.NGW = c.G * NWAVES; return c; }
#define WSP(T, off) ((T*)(A->ws + (off)))
struct CJob { const float* W; const float* g; bf16* WT; int N, ldk, koff, it; };
DI CJob conv_resolve(int item, int l, KArgs A) {
    constexpr int I_UP = (512 / 64) * (D / 32), I_O = (D / 64) * (D / 32), I_F1 = (D / 64) * (FF / 32), I_F2 = (FF / 64) * (D / 32), I_PE = (PLE / 64) * (D / 32), I_PG = I_O;
    CJob j;
    if (item < I_F1) { j = CJob{A->in[6] + (size_t)l * D * FF, A->in[11] + l * D, WSP(bf16, WS_WFF1), FF, D, 0, item}; return j; } item -= I_F1;
    if (item < I_F2) { j = CJob{A->in[7] + (size_t)l * FF * D, nullptr, WSP(bf16, WS_WFF2), D, FF, 0, item}; return j; } item -= I_F2;
    if (item < I_UP) { j = CJob{A->in[3] + (size_t)l * 512 * D, nullptr, WSP(bf16, WS_WUP), D, D, 0, item}; return j; } item -= I_UP;
    if (item < I_UP) { j = CJob{A->in[4] + (size_t)l * 512 * D, nullptr, WSP(bf16, WS_WUP), D, D, 512, item}; return j; } item -= I_UP;
    if (item < I_O) { j = CJob{A->in[5] + (size_t)l * D * D, nullptr, WSP(bf16, WS_WO), D, D, 0, item}; return j; } item -= I_O;
    if (item < I_PG) { j = CJob{A->in[9] + (size_t)l * D * D, A->in[12] + l * D, WSP(bf16, WS_WPG), D, D, 0, item}; return j; } item -= I_PG;
    j = CJob{A->in[8] + (size_t)l * PLE * D, nullptr, WSP(bf16, WS_WPE), D, PLE, 0, item}; return j;
}
constexpr int CONV_LATER_ITEMS = 2 * (512 / 64) * (D / 32) + 2 * (D / 64) * (D / 32) + (D / 64) * (FF / 32) + (FF / 64) * (D / 32) + (PLE / 64) * (D / 32);
DI void conv_later(int l, KArgs A, LAS float* scr, int gw, int NGW, int lane) {
    for (int item = gw; item < CONV_LATER_ITEMS; item += NGW) {
        const CJob j = conv_resolve(item, l, A);
        const int nblk = j.N / 32, kb = j.it / nblk, nb = j.it % nblk, k0 = 64 * kb, n0 = 32 * nb;
        const float* wp = j.W + (size_t)(k0 + (lane >> 5)) * j.N + n0 + (lane & 31);
        float cur[32];
#pragma unroll
        for (int i = 0; i < 32; ++i) cur[i] = wp[(size_t)(2 * i) * j.N];
        f32x4 g0, g1;
        if (j.g) { g0 = *(const f32x4*)(j.g + k0 + 8 * (lane & 7)); g1 = *(const f32x4*)(j.g + k0 + 8 * (lane & 7) + 4); }
#pragma unroll
        for (int i = 0; i < 32; ++i) scr[(2 * i + (lane >> 5)) * 33 + (lane & 31)] = cur[i];
        asm volatile("s_waitcnt lgkmcnt(0)" ::: "memory");
        const int c = lane & 7;
#pragma unroll
        for (int jj = 0; jj < 4; ++jj) { const int n = (lane >> 3) + 8 * jj; const LAS float* s = scr + (8 * c) * 33 + n;
            u32x4 o;
            if (j.g) { o.x = cvtpk(s[0 * 33] * g0[0], s[1 * 33] * g0[1]); o.y = cvtpk(s[2 * 33] * g0[2], s[3 * 33] * g0[3]); o.z = cvtpk(s[4 * 33] * g1[0], s[5 * 33] * g1[1]); o.w = cvtpk(s[6 * 33] * g1[2], s[7 * 33] * g1[3]); }
            else { o.x = cvtpk(s[0 * 33], s[1 * 33]); o.y = cvtpk(s[2 * 33], s[3 * 33]); o.z = cvtpk(s[4 * 33], s[5 * 33]); o.w = cvtpk(s[6 * 33], s[7 * 33]); }
            *(u32x4*)(j.WT + (size_t)(n0 + n) * j.ldk + j.koff + k0 + 8 * c) = o; }
        asm volatile("s_waitcnt lgkmcnt(0)" ::: "memory");
    }
}
__global__ void __launch_bounds__(NWAVES * 64, 2) mk_fwd(Args args_unused) {
    extern __shared__ __attribute__((aligned(16))) unsigned char lds_raw[];
    LAS unsigned char* lds = (LAS unsigned char*)lds_raw;
    volatile LAS unsigned* MISC = (volatile LAS unsigned*)(lds + MISC_OFF);
    const int wv = __builtin_amdgcn_readfirstlane(threadIdx.x >> 6);
    for (int u = threadIdx.x; u < (LDS_BYTES - RING_BYTES) / 4; u += NWAVES * 64) ((LAS unsigned*)(lds + RING_BYTES))[u] = 0u;
    __syncthreads();
    int lo, hi;
    if (PROBE_TS >= 0 && blockIdx.x == 0 && threadIdx.x == 0) { KArgs A = kargs(); WSP(unsigned long long, WS_CTL + 32768)[31] = __builtin_amdgcn_s_memrealtime(); }
    XcdBarrier bar;
    { KArgs A = kargs(); lo = A->ph_lo; hi = A->ph_hi; bar.bar = WSP(unsigned, WS_CTL) + CW_BAR; bar.x = 0; bar.st = nullptr;
      if (MK_N_LAUNCHES == 1) bar = xcd_barrier_post(WSP(unsigned, WS_CTL) + CW_BAR, MISC + 8); }
#define IN(k) (lo <= (k) && (k) < hi)
#define STAMP(k) do { if (PROBE_TS >= 0 && blockIdx.x == 0) { const Ctx cs_ = ctx(wv); if (cs_.tid == 0) { KArgs A = kargs(); WSP(unsigned long long, WS_CTL + 32768)[(k)] = __builtin_amdgcn_s_memrealtime(); } } } while (0)
#ifndef PROBE_REP
#define PROBE_REP 0
#endif
#define REP_BEGIN(j) for (int rep_ = 0; rep_ <= ((PROBE_REP >> (j)) & 1); ++rep_) {
#define REP_END(j) if (rep_ < ((PROBE_REP >> (j)) & 1)) { XcdBarrier b_ = bar; asm volatile("" : "+s"(b_.bar)); const Ctx cb_ = ctx(wv); xcd_barrier(b_, cb_.tid == 0); } }
#define SEAM(k) do { if (IN(k) && IN((k) + 1)) { XcdBarrier b_ = bar; asm volatile("" : "+s"(b_.bar)); const Ctx cb_ = ctx(wv); xcd_barrier(b_, cb_.tid == 0); } STAMP(k); } while (0)
#define CONV(W, g, WT, K, N, ldk, koff, perm) conv_w((W), (g), (WT), (K), (N), (ldk), (koff), (perm), (LAS float*)(lds + c.wave * 16384), c.gw, c.NGW, c.lane)

    REP_BEGIN(7)
    if (IN(0)) {
        KArgs A = kargs(); const Ctx c = ctx(wv);
        float* BT = WSP(float, WS_BT);
        if (c.bx == 0) { const float* rel_bias = A->in[15]; const float* sinks = A->in[14];
            for (int i = c.tid; i < 8 * 128; i += NWAVES * 64) { const int h = i >> 7, d = i & 127; BT[i] = rel_bias[t5_bucket(d) * 8 + h] * LOG2E; }
            if (c.tid < 16) BT[1024 + c.tid] = sinks[c.tid] * LOG2E; }
        CONV(A->in[2], A->in[10], WSP(bf16, WS_WIN), D, NIN, D, 0, true);
        rownorm_rows(A->in[0], WSP(bf16, WS_XB), WSP(float, WS_SS), c.gw, c.NGW, c.lane);
        __syncthreads();
    }
    REP_END(7)
    SEAM(0);
#pragma unroll 1
    for (int l = 0; l < DEPTH; ++l) {
        const int pb = 1 + 7 * l;
#define SSA WSP(float, WS_SS + (l == 0 ? 0 : (size_t)M * 16))
#define SSB WSP(float, WS_SS + (l == 0 ? (size_t)M * 16 : 0))
        REP_BEGIN(0)
        if (IN(pb)) {
            KArgs A = kargs(); const Ctx c = ctx(wv);
            pg8::Gemm g{WSP(bf16, WS_XB), WSP(bf16, WS_WIN), M, NIN, D}; pg8::StaticOrder S; S.init(M, NIN, c.G, c.bx);
            EpiIn E{SSA, WSP(bf16, WS_QKV), WSP(bf16, WS_GATE)};
            pg8::gemm_phase<EpiIn, pg8::StaticOrder, true, true>(lds, g, S, E, c.tid);
        }
        if (IN(pb)) {
            KArgs A = kargs(); const Ctx c = ctx(wv);
            const int skip = (c.G == 256) ? ((M / 256) * (NIN / 256)) % 256 : 0;
            if (c.bx >= skip && rep_ == ((PROBE_REP >> 0) & 1)) {
                const int gw2 = (c.bx - skip) * NWAVES + c.wave, NGW2 = (c.G - skip) * NWAVES; LAS float* scr = (LAS float*)(lds + c.wave * 16384);
                conv_later(l, A, scr, gw2, NGW2, c.lane);
                if (l == 0) { const float* p_in = A->in[1]; bf16* PB = WSP(bf16, WS_PB);
                    const size_t st_ = (size_t)(c.G - skip) * NWAVES * 64, n4_ = (size_t)DEPTH * M * PLE / 4;
                    size_t i = (size_t)(c.bx - skip) * (NWAVES * 64) + c.tid;
                    for (; i + 3 * st_ < n4_; i += 4 * st_) { f32x4 v[4];
#pragma unroll
                        for (int j = 0; j < 4; ++j) v[j] = ((const f32x4*)p_in)[i + j * st_];
#pragma unroll
                        for (int j = 0; j < 4; ++j) { u32x2 o; o.x = cvtpk(v[j][0], v[j][1]); o.y = cvtpk(v[j][2], v[j][3]); ((u32x2*)PB)[i + j * st_] = o; } }
                    for (; i < n4_; i += st_) { const f32x4 v = ((const f32x4*)p_in)[i]; u32x2 o; o.x = cvtpk(v[0], v[1]); o.y = cvtpk(v[2], v[3]); ((u32x2*)PB)[i] = o; } }
            }
            __syncthreads();
        }
        REP_END(0)
        SEAM(pb);
        REP_BEGIN(1)
        if (IN(pb + 1)) {
            KArgs A = kargs(); const Ctx c = ctx(wv);
            if (l == 0) { CONV(A->in[2] + (size_t)D * NIN, A->in[10] + D, WSP(bf16, WS_WIN), D, NIN, D, 0, true); __syncthreads(); }
            __syncthreads();
            { LAS char* wl = (LAS char*)lds + c.wave * 16384;
              LAS float* btl = (LAS float*)(lds + RING_BYTES + 1024) + c.wave * 192; LAS float* wsf = btl + 128;
#ifndef PROBE_ATT
#define PROBE_ATT 0
#endif
              for (int ra_ = 0; ra_ <= (PROBE_ATT & 1); ++ra_)
              for (int u = c.gw; u < BATCH * 8 * (SEQ / 32); u += c.NGW) { const int bh = u >> 7, qb = u & 127; att::sbw_unit<true>(bh >> 3, bh & 7, qb, WSP(bf16, WS_QKV), WSP(bf16, WS_ATT), wl, c.lane); }
              for (int ra_ = 0; ra_ <= ((PROBE_ATT >> 1) & 1); ++ra_)
              for (int u = c.gw; u < BATCH * 8 * (SEQ / 32); u += c.NGW) { const int bh = u >> 7, qb = u & 127; att::swaw_unit(bh >> 3, bh & 7, qb, l, WSP(bf16, WS_QKV), WSP(float, WS_BT), WSP(bf16, WS_ATT), wl, btl, wsf, c.lane); } }
        }
        REP_END(1)
        SEAM(pb + 1);
        REP_BEGIN(2)
        if (IN(pb + 2)) {
            KArgs A = kargs(); const Ctx c = ctx(wv);
            pg8::Gemm g{WSP(bf16, WS_ATT), WSP(bf16, WS_WUP), M, D, D}; pg8::StaticOrder S; S.init(M, D, c.G, c.bx);
            EpiUp E{WSP(bf16, WS_GATE), WSP(bf16, WS_MRG)};
            pg8::gemm_phase<EpiUp, pg8::StaticOrder, true, true>(lds, g, S, E, c.tid);
        }
        REP_END(2)
        SEAM(pb + 2);
        for (int rep_ = 0; rep_ <= (l == 0 ? ((PROBE_REP >> 3) & 1) : 0); ++rep_) {
        if (IN(pb + 3)) {
            KArgs A = kargs(); const Ctx c = ctx(wv);
            if (c.G == 256) {
                pg8::Gemm g{WSP(bf16, WS_MRG), WSP(bf16, WS_WO), M, D, D}; pg8::StaticOrder S; S.init(M, D, c.G, c.bx);
                if (l == 0) { EpiRes<false, true> E{A->in[0], nullptr, WSP(bf16, WS_XB), SSB, nullptr, nullptr, false, bar};
                    pg8::gemm_phase<EpiRes<false, true>, pg8::StaticOrder, false, true>(lds, g, S, E, c.tid); }
                else { EpiRes<false, false> E{nullptr, WSP(bf16, WS_XB), WSP(bf16, WS_XB), SSB, nullptr, nullptr, false, bar};
                    pg8::gemm_phase<EpiRes<false, false>, pg8::StaticOrder, false, true>(lds, g, S, E, c.tid); }
            }
        }
        if (rep_ < (l == 0 ? ((PROBE_REP >> 3) & 1) : 0)) { XcdBarrier b_ = bar; asm volatile("" : "+s"(b_.bar)); const Ctx cb_ = ctx(wv); xcd_barrier(b_, cb_.tid == 0); } }
        SEAM(pb + 3);
        REP_BEGIN(4)
        if (IN(pb + 4)) {
            KArgs A = kargs(); const Ctx c = ctx(wv);
            { pg8::Gemm g{WSP(bf16, WS_XB), WSP(bf16, WS_WFF1), M, FF, D}; pg8::StaticOrder S; S.init(M, FF, c.G, c.bx);
              EpiFf1 E{SSB, WSP(bf16, WS_U)};
              pg8::gemm_phase<EpiFf1, pg8::StaticOrder, true, true>(lds, g, S, E, c.tid); }
        }
        if (IN(pb + 4)) {
            KArgs A = kargs(); const Ctx c = ctx(wv);
            { pg8::Gemm g{WSP(bf16, WS_PB) + (size_t)l * M * PLE, WSP(bf16, WS_WPE), M, D, PLE}; pg8::StaticOrder S; S.init(M, D, c.G, c.bx);
              EpiPe E{WSP(bf16, WS_PE)};
              pg8::gemm_phase<EpiPe, pg8::StaticOrder, true, true>(lds, g, S, E, c.tid); }
        }
        REP_END(4)
        SEAM(pb + 4);
        if (IN(pb + 5)) {
            KArgs A = kargs(); const Ctx c = ctx(wv);
            if (c.G == 256) {
                pg8::Gemm g{WSP(bf16, WS_U), WSP(bf16, WS_WFF2), M, D, FF}; pg8::StaticOrder S; S.init(M, D, c.G, c.bx);
                for (int rep_ = ((PROBE_REP >> 5) & 1); rep_ >= 0; --rep_) { EpiRes<false, false> E{nullptr, WSP(bf16, WS_XB), WSP(bf16, WS_XB), SSA, nullptr, nullptr, rep_ != 0, bar};
                pg8::gemm_phase<EpiRes<false, false>, pg8::StaticOrder, false, true>(lds, g, S, E, c.tid); }
            }
        }
        SEAM(pb + 5);
        if (IN(pb + 6)) {
            KArgs A = kargs(); const Ctx c = ctx(wv);
            if (c.G == 256) {
                pg8::Gemm g{WSP(bf16, WS_XB), WSP(bf16, WS_WPG), M, D, D}; pg8::StaticOrder S; S.init(M, D, c.G, c.bx);
                for (int rep_ = ((PROBE_REP >> 6) & 1); rep_ >= 0; --rep_) { XcdBarrier b_ = bar; asm volatile("" : "+s"(b_.bar)); EpiRes<true, false> E{nullptr, WSP(bf16, WS_XB), WSP(bf16, WS_XB), SSB, WSP(bf16, WS_PE), SSA, rep_ != 0, b_};
                pg8::gemm_phase<EpiRes<true, false>, pg8::StaticOrder, false, true>(lds, g, S, E, c.tid); }
            }
        }
        SEAM(pb + 6);
    }
#ifdef PROBE_XBAR
    for (int xb_ = 0; xb_ < PROBE_XBAR; ++xb_) { XcdBarrier b_ = bar; asm volatile("" : "+s"(b_.bar)); const Ctx cb_ = ctx(wv); xcd_barrier(b_, cb_.tid == 0); }
#endif
    if (IN(NPH - 1)) { KArgs A = kargs(); const Ctx c = ctx(wv); for (int rep_ = ((PROBE_REP >> 8) & 1); rep_ >= 0; --rep_) final_rows(WSP(bf16, WS_XB), A->out, WSP(float, WS_SS), A->in[13], c.gw, c.NGW, c.lane, rep_ != 0); }
    if (PROBE_TS >= 0) {
        __syncthreads(); KArgs A = kargs(); const Ctx c = ctx(wv); const unsigned long long* ts = WSP(unsigned long long, WS_CTL + 32768);
        const unsigned long long t1 = __hip_atomic_load(ts + PROBE_TS, __ATOMIC_RELAXED, __HIP_MEMORY_SCOPE_AGENT), t0 = __hip_atomic_load(ts + (PROBE_TS == 0 ? 31 : PROBE_TS - 1), __ATOMIC_RELAXED, __HIP_MEMORY_SCOPE_AGENT);
        const float V = (float)(t1 - t0) * (0.01f / 30.0f);
        for (size_t i = (size_t)c.vcu * (NWAVES * 64) + c.tid; i < (size_t)M * D / 4; i += (size_t)c.G * NWAVES * 64) ((f32x4*)A->out)[i] = (f32x4){V, V, V, V};
    }
#undef IN
#undef SEAM
#undef CONV
}

extern "C" void kernel_launch(void* const* d_in, const int* in_sizes, int n_in, void* d_out, int out_size, void* d_ws, size_t ws_size, hipStream_t stream) {
    static int grid = 0;
    if (grid == 0) {
        if (n_in != 16 || in_sizes[0] != M * D || out_size != M * D || ws_size < WS_END) { fprintf(stderr, "kernel_launch: unexpected shapes (n_in %d, in0 %d, out %d, ws %zu); nothing launched\n", n_in, n_in > 0 ? in_sizes[0] : -1, out_size, ws_size); grid = -1; return; }
        int dev = 0, cus = 0, per_cu = 0;
        if (hipGetDevice(&dev) != hipSuccess || hipDeviceGetAttribute(&cus, hipDeviceAttributeMultiprocessorCount, dev) != hipSuccess) { fprintf(stderr, "kernel_launch: device query failed\n"); grid = -1; return; }
        if (hipFuncSetAttribute((const void*)mk_fwd, hipFuncAttributeMaxDynamicSharedMemorySize, LDS_BYTES) != hipSuccess) { fprintf(stderr, "kernel_launch: hipFuncSetAttribute failed\n"); grid = -1; return; }
        if (hipOccupancyMaxActiveBlocksPerMultiprocessor(&per_cu, (const void*)mk_fwd, NWAVES * 64, LDS_BYTES) != hipSuccess || per_cu < 1) fprintf(stderr, "kernel_launch: note: occupancy query reports %d workgroups per CU\n", per_cu);
        (void)hipGetLastError();
        grid = cus;
        if (grid != 256) fprintf(stderr, "kernel_launch: %d CUs; the single-unit GEMM phases need exactly 256 workgroups\n", grid);
    }
    if (grid < 0) return;
    if (hipMemsetAsync((char*)d_ws + WS_CTL, 0, CTL_ZERO_BYTES, stream) != hipSuccess) { fprintf(stderr, "kernel_launch: memset failed\n"); return; }
    Args a{};
    for (int i = 0; i < 16; ++i) a.in[i] = (const float*)d_in[i];
    a.out = (float*)d_out; a.ws = (unsigned char*)d_ws;
    if (MK_N_LAUNCHES == 1) { a.ph_lo = 0; a.ph_hi = NPH; hipLaunchKernelGGL(mk_fwd, dim3(grid), dim3(NWAVES * 64), LDS_BYTES, stream, a); }
    else for (int li = 0; li < NPH; ++li) { a.ph_lo = li; a.ph_hi = li + 1; hipLaunchKernelGGL(mk_fwd, dim3(grid), dim3(NWAVES * 64), LDS_BYTES, stream, a); }
    const hipError_t le = hipPeekAtLastError();
    if (le != hipSuccess) fprintf(stderr, "kernel_launch: launch failed: %s\n", hipGetErrorName(le));
}
```

```cpp
#include <hip/hip_runtime.h>
#include <cstdio>
#include <cstdint>
#define LAS __attribute__((address_space(3)))

namespace pg8 {
#define PG8_LAS __attribute__((address_space(3)))
typedef unsigned short bf16_t;
typedef short bf16x8 __attribute__((ext_vector_type(8)));
typedef float f32x4 __attribute__((ext_vector_type(4)));
typedef unsigned u32x4 __attribute__((ext_vector_type(4)));
constexpr int BM = 256, BK = 64, HALF = 128, HTB = HALF * BK * 2  , STAGE_BYTES = 8 * HTB, NXCD = 8, WGM = 8;

__host__ __device__ __forceinline__ int lds_byte(int r, int c) { const int st = (r >> 4) * 2 + (c >> 5), rr = r & 15, cc = c & 31, ob = rr * 64 + cc * 2; return st * 1024 + (ob ^ (((ob >> 9) & 1) << 5)); }
__host__ __device__ __forceinline__ void stage_rc(int b, int& R, int& C) { const int st = b / 1024, sb = b % 1024, swz = sb ^ (((sb >> 9) & 1) << 5); R = (st >> 1) * 16 + swz / 64; C = (st & 1) * 32 + (swz % 64) / 2; }
__host__ __device__ __forceinline__ int perm32(int rho) { const int n = rho >> 4, i = rho & 15; return 8 * (i >> 2) + 4 * n + (i & 3); }

struct Unit { int pm, pn, idx; };
struct Gemm { const bf16_t* A; const bf16_t* Bt; int M, N, K; };

struct StaticOrder {
    int nM, nN, nwg, G, c;
    __host__ __device__ void init(int M, int N, int G_, int c_) { nM = M / BM; nN = N / BM; nwg = nM * nN; G = G_; c = c_; }
    __host__ __device__ bool next(int i, Unit& u) const {
        const long L = (long)i * G + c; if (L >= nwg) return false;
        int wgid = (int)L; { const int q = nwg / NXCD, r = nwg % NXCD, xcd = wgid % NXCD, off = wgid / NXCD; wgid = (xcd < r ? xcd * (q + 1) : r * (q + 1) + (xcd - r) * q) + off; }
        const int nig = WGM * nN, gid = wgid / nig, fm = gid * WGM, gsz = (nM - fm) < WGM ? (nM - fm) : WGM;
        u.pm = fm + ((wgid % nig) % gsz); u.pn = (wgid % nig) / gsz; u.idx = i; return true;
    }
    __device__ __forceinline__ void a_ready(const Unit&) const {}
    __device__ __forceinline__ void done(const Unit&) const {}
};

__device__ __forceinline__ unsigned cvt_pk_bf16(float lo, float hi) { unsigned r; asm volatile("v_cvt_pk_bf16_f32 %0, %1, %2" : "=v"(r) : "v"(lo), "v"(hi)); return r; }
template <class Epi, class Sched, bool ALIGN_EPI = false, bool SP2 = false>
__device__ __forceinline__ void gemm_phase(PG8_LAS unsigned char* lds, const Gemm g, const Sched& S, const Epi& E, const int tid_in) {
    int tid_ = tid_in; asm volatile("" : "+v"(tid_));
    const int tid = tid_, wid = __builtin_amdgcn_readfirstlane(tid >> 6), lane = tid & 63, wr = wid >> 2, wc = wid & 3, fr = lane & 15, fq = lane >> 4;
    int K_ = g.K; asm volatile("" : "+s"(K_));
    const int K = K_, nt = K / BK;
    unsigned voffA[2], voffB[2];
#pragma unroll
    for (int i = 0; i < 2; ++i) { int R, C; stage_rc(tid * 16 + i * 8192, R, C); const int Rb = Epi::PERM ? ((R & ~31) + perm32(R & 31)) : R;
        voffA[i] = (unsigned)(R * K + C) * 2u; voffB[i] = (unsigned)(Rb * K + C) * 2u; }
    const size_t kstep = (size_t)(BK * 2);
    const size_t hstep = (size_t)HALF * K * 2;
    const size_t tstep = 2 * hstep;
    const unsigned ldsw = (unsigned)wid * 1024u;
    const int aoff = lds_byte(wr * 64 + fr, fq * 8), boff = lds_byte(wc * 32 + fr, fq * 8);
#define PG8_SA(b, h) (((b) * 2 + (h)) * HTB)
#define PG8_SB(b, h) ((4 + (b) * 2 + (h)) * HTB)
#define PG8_STAGE(bufoff, gbase, voff) do { _Pragma("unroll") for (int _i = 0; _i < 2; ++_i) \
        __builtin_amdgcn_global_load_lds((const unsigned*)((const char*)(gbase) + (voff)[_i]), (PG8_LAS unsigned*)(lds + (bufoff) + ldsw + _i * 8192), 16, 0, 0); } while (0)
#define PG8_LDA(dst, b, h) do { _Pragma("unroll") for (int m = 0; m < 4; ++m) _Pragma("unroll") for (int k = 0; k < 2; ++k) dst[m][k] = *(const PG8_LAS bf16x8*)(lds + PG8_SA(b, h) + aoff + m * 2048 + k * 1024); } while (0)
#define PG8_LDB(dst, b, h) do { _Pragma("unroll") for (int n = 0; n < 2; ++n) _Pragma("unroll") for (int k = 0; k < 2; ++k) dst[n][k] = *(const PG8_LAS bf16x8*)(lds + PG8_SB(b, h) + boff + n * 2048 + k * 1024); } while (0)
#define PG8_MMA(ai, bj, At, Bt) do { __builtin_amdgcn_s_setprio(1); _Pragma("unroll") for (int m = 0; m < 4; ++m) _Pragma("unroll") for (int n = 0; n < 2; ++n) _Pragma("unroll") for (int k = 0; k < 2; ++k) \
        acc[ai][bj][m][n] = __builtin_amdgcn_mfma_f32_16x16x32_bf16(Bt[n][k], At[m][k], acc[ai][bj][m][n], 0, 0, 0); __builtin_amdgcn_s_setprio(0); } while (0)
#define PG8_WAIT_V(n) asm volatile("s_waitcnt vmcnt(" #n ")" ::: "memory")
#define PG8_WAIT_L(n) asm volatile("s_waitcnt lgkmcnt(" #n ")" ::: "memory")
#define PG8_BAR __builtin_amdgcn_s_barrier()
#define PG8_SCHED __builtin_amdgcn_sched_barrier(0)
    Unit cur, nxt; int ui = 0;
    if (!S.next(0, cur)) return;
    f32x4 acc[2][2][4][2];
#pragma unroll
    for (int a = 0; a < 2; ++a)
#pragma unroll
        for (int b = 0; b < 2; ++b)
#pragma unroll
            for (int m = 0; m < 4; ++m)
#pragma unroll
                for (int n = 0; n < 2; ++n) acc[a][b][m][n] = (f32x4){0.f, 0.f, 0.f, 0.f};
    bf16x8 At[4][2], B0[2][2], B1[2][2];
    const char* cA = (const char*)g.A + (size_t)cur.pm * tstep; const char* cB = (const char*)g.Bt + (size_t)cur.pn * tstep;
    S.a_ready(cur);
    if constexpr (SP2) {
        PG8_STAGE(PG8_SB(0, 0), cB, voffB); PG8_STAGE(PG8_SB(0, 1), cB + hstep, voffB); PG8_STAGE(PG8_SA(0, 0), cA, voffA); PG8_STAGE(PG8_SA(0, 1), cA + hstep, voffA);
        if (wr == 1) PG8_BAR;
        PG8_WAIT_V(2); PG8_BAR;
        PG8_STAGE(PG8_SB(1, 0), cB + kstep, voffB); PG8_STAGE(PG8_SA(1, 0), cA + kstep, voffA); PG8_STAGE(PG8_SB(1, 1), cB + hstep + kstep, voffB);
        PG8_WAIT_V(6); PG8_BAR;
    } else {
        PG8_STAGE(PG8_SB(0, 0), cB, voffB); PG8_STAGE(PG8_SA(0, 0), cA, voffA); PG8_STAGE(PG8_SB(0, 1), cB + hstep, voffB); PG8_STAGE(PG8_SA(0, 1), cA + hstep, voffA);
        if (wr == 1) PG8_BAR;
        PG8_WAIT_V(4); PG8_BAR;
        PG8_STAGE(PG8_SB(1, 0), cB + kstep, voffB); PG8_STAGE(PG8_SA(1, 0), cA + kstep, voffA); PG8_STAGE(PG8_SB(1, 1), cB + hstep + kstep, voffB);
        PG8_WAIT_V(6); PG8_BAR;
    }
    for (;;) {
        const bool has_next = S.next(ui + 1, nxt);
        const char* nA = has_next ? (const char*)g.A + (size_t)nxt.pm * tstep : cA; const char* nB = has_next ? (const char*)g.Bt + (size_t)nxt.pn * tstep : cB;
        for (int t = 0; t < nt; t += 2) {
            const bool last = (t == nt - 2);
            if constexpr (Epi::MIDSCALE) { if (t == (nt >> 1)) E.mid(acc, cur, wr, wc, fr, fq); }
            const char* a1 = cA + (size_t)(t + 1) * kstep;
            const char* a2 = last ? nA : cA + (size_t)(t + 2) * kstep; const char* b2 = last ? nB : cB + (size_t)(t + 2) * kstep;
            const char* a3 = a2 + kstep; const char* b3 = b2 + kstep;
            if (last && has_next) S.a_ready(nxt);
            if constexpr (SP2) {
            PG8_LDB(B0, 0, 0); PG8_LDB(B1, 0, 1); PG8_SCHED; PG8_LDA(At, 0, 0); PG8_STAGE(PG8_SA(1, 1), a1 + hstep, voffA);
            PG8_WAIT_V(8); PG8_WAIT_L(0); PG8_BAR; PG8_MMA(0, 0, At, B0); PG8_MMA(0, 1, At, B1); PG8_BAR; PG8_SCHED;
            PG8_LDA(At, 0, 1); PG8_STAGE(PG8_SB(0, 0), b2, voffB); PG8_STAGE(PG8_SB(0, 1), b2 + hstep, voffB); PG8_STAGE(PG8_SA(0, 0), a2, voffA);
            PG8_WAIT_V(8); PG8_WAIT_L(0); PG8_BAR; PG8_MMA(1, 0, At, B0); PG8_MMA(1, 1, At, B1); PG8_BAR; PG8_SCHED;
            PG8_LDB(B0, 1, 0); PG8_LDB(B1, 1, 1); PG8_SCHED; PG8_LDA(At, 1, 0); PG8_STAGE(PG8_SA(0, 1), a2 + hstep, voffA);
            PG8_WAIT_V(8); PG8_WAIT_L(0); PG8_BAR; PG8_MMA(0, 0, At, B0); PG8_MMA(0, 1, At, B1); PG8_BAR; PG8_SCHED;
            PG8_LDA(At, 1, 1); PG8_STAGE(PG8_SB(1, 0), b3, voffB); PG8_STAGE(PG8_SB(1, 1), b3 + hstep, voffB); PG8_STAGE(PG8_SA(1, 0), a3, voffA);
            PG8_WAIT_V(8); PG8_WAIT_L(0); PG8_BAR; PG8_MMA(1, 0, At, B0); PG8_MMA(1, 1, At, B1); PG8_BAR; PG8_SCHED;
            } else {
            PG8_LDB(B0, 0, 0); PG8_SCHED; PG8_LDA(At, 0, 0); PG8_STAGE(PG8_SA(1, 1), a1 + hstep, voffA);
            PG8_WAIT_L(8); PG8_BAR; PG8_WAIT_L(0); PG8_MMA(0, 0, At, B0); PG8_BAR; PG8_SCHED;
            PG8_LDB(B1, 0, 1); PG8_STAGE(PG8_SB(0, 0), b2, voffB);
            PG8_BAR; PG8_WAIT_L(0); PG8_MMA(0, 1, At, B1); PG8_BAR;
            PG8_LDA(At, 0, 1); PG8_STAGE(PG8_SA(0, 0), a2, voffA);
            PG8_BAR; PG8_WAIT_L(0); PG8_MMA(1, 0, At, B0); PG8_BAR; PG8_SCHED;
            PG8_STAGE(PG8_SB(0, 1), b2 + hstep, voffB);
            PG8_WAIT_V(6); PG8_BAR; PG8_MMA(1, 1, At, B1); PG8_BAR;
            PG8_LDB(B0, 1, 0); PG8_SCHED; PG8_LDA(At, 1, 0); PG8_STAGE(PG8_SA(0, 1), a2 + hstep, voffA);
            PG8_WAIT_L(8); PG8_BAR; PG8_WAIT_L(0); PG8_MMA(0, 0, At, B0); PG8_BAR; PG8_SCHED;
            PG8_LDB(B1, 1, 1); PG8_STAGE(PG8_SB(1, 0), b3, voffB);
            PG8_BAR; PG8_WAIT_L(0); PG8_MMA(0, 1, At, B1); PG8_BAR;
            PG8_LDA(At, 1, 1); PG8_STAGE(PG8_SA(1, 0), a3, voffA);
            PG8_BAR; PG8_WAIT_L(0); PG8_MMA(1, 0, At, B0); PG8_BAR; PG8_SCHED;
            PG8_STAGE(PG8_SB(1, 1), b3 + hstep, voffB);
            PG8_WAIT_V(6); PG8_BAR; PG8_MMA(1, 1, At, B1); PG8_BAR;
            }
        }
        if constexpr (ALIGN_EPI) { if (wr == 0) PG8_BAR; }
        if constexpr (!Epi::AFTER_DRAIN) { E(acc, cur, wr, wc, fr, fq); S.done(cur); }
        if (!has_next) break;
#pragma unroll
        for (int a = 0; a < 2; ++a)
#pragma unroll
            for (int b = 0; b < 2; ++b)
#pragma unroll
                for (int m = 0; m < 4; ++m)
#pragma unroll
                    for (int n = 0; n < 2; ++n) acc[a][b][m][n] = (f32x4){0.f, 0.f, 0.f, 0.f};
        cur = nxt; cA = nA; cB = nB; ++ui;
        if constexpr (ALIGN_EPI) { if (wr == 1) PG8_BAR; }
    }
    PG8_WAIT_V(0);
    if constexpr (!ALIGN_EPI) { if (wr == 0) PG8_BAR; }
    PG8_BAR;
    if constexpr (Epi::AFTER_DRAIN) { E.fused(acc, cur, wr, wc, fr, fq, lds, wid, lane); S.done(cur); }
#undef PG8_SA
#undef PG8_SB
#undef PG8_STAGE
#undef PG8_LDA
#undef PG8_LDB
#undef PG8_MMA
#undef PG8_WAIT_V
#undef PG8_WAIT_L
#undef PG8_BAR
#undef PG8_SCHED
}
}

#define XB_TMO      128
#define XB_XCNT(j)  (256  + 64 * (j))
#define XB_XSUB(j)  (1280 + 64 * (j))
#define XB_XGEN(j)  (2304 + 64 * (j))
#define XB_TOP      3328
#define XB_TOPGEN   3392
#define XCD_BAR_WORDS 3456
#define XB_SPIN_CAP (1u << 18)

__device__ __forceinline__ unsigned xb_ld(unsigned* p)              { return __hip_atomic_load(p, __ATOMIC_RELAXED, __HIP_MEMORY_SCOPE_AGENT); }
__device__ __forceinline__ unsigned xb_add(unsigned* p, unsigned v) { return __hip_atomic_fetch_add(p, v, __ATOMIC_RELAXED, __HIP_MEMORY_SCOPE_AGENT); }
__device__ __forceinline__ unsigned xb_xcc_id() { return (unsigned)__builtin_amdgcn_s_getreg((3 << 11) | 20) & 0xFu; }
#define XB_SPIN(cond, bar) do { unsigned _sp = 0; while (cond) { __builtin_amdgcn_s_sleep(1); \
    if ((++_sp & 255u) == 0u) { if (xb_ld(&(bar)[XB_TMO])) break; if (_sp > XB_SPIN_CAP) { atomicAdd(&(bar)[XB_TMO], 1u); break; } } } } while (0)

struct XcdBarrier {
    unsigned* bar; unsigned x;
    volatile LAS unsigned* st;
};

__device__ __forceinline__ XcdBarrier xcd_barrier_post(unsigned* bar, volatile LAS unsigned* st) {
    XcdBarrier b; b.bar = bar; b.x = xb_xcc_id(); b.st = st;
    if (threadIdx.x == 0) (void)xb_add(&bar[XB_XCNT(b.x)], 1u);
    return b;
}
__device__ __forceinline__ void xcd_barrier_complete(unsigned* bar, unsigned x, unsigned& nloc, unsigned& nx) {
    const unsigned G = gridDim.x * gridDim.y * gridDim.z;
    unsigned sum, cnt, mine, sp = 0u;
    for (;;) {
        sum = 0u; cnt = 0u; mine = 0u;
#pragma unroll
        for (unsigned j = 0; j < 16; ++j) { const unsigned c = xb_ld(&bar[XB_XCNT(j)]); sum += c; cnt += (c > 0u) ? 1u : 0u; mine = (j == x) ? c : mine; }
        if (sum == G) break;
        __builtin_amdgcn_s_sleep(1);
        if ((++sp & 255u) == 0u) { if (xb_ld(&bar[XB_TMO])) break; if (sp > XB_SPIN_CAP) { atomicAdd(&bar[XB_TMO], 1u); break; } }
    }
    nloc = mine > 0u ? mine : 1u; nx = cnt > 0u ? cnt : 1u;
}

__device__ __forceinline__ void xcd_barrier(const XcdBarrier& b, const bool is_t0  ) {
    asm volatile("s_waitcnt vmcnt(0)" ::: "memory");
    __syncthreads();
    if (is_t0) {
        unsigned* bar = b.bar;
        __builtin_amdgcn_s_waitcnt(0);
        unsigned nloc = b.st[0], nx = b.st[1];
        if (nloc == 0u) { xcd_barrier_complete(bar, b.x, nloc, nx); b.st[0] = nloc; b.st[1] = nx; }
        const unsigned old = xb_add(&bar[XB_XSUB(b.x)], 1u);
        const unsigned gen = old / nloc;
        if (old + 1u == (gen + 1u) * nloc) {
            __builtin_amdgcn_fence(__ATOMIC_RELEASE, "agent");
            asm volatile("s_waitcnt vmcnt(0)" ::: "memory");
            const unsigned og = xb_add(&bar[XB_TOP], 1u);
            const unsigned tg = og / nx;
            if (og + 1u == (tg + 1u) * nx) xb_add(&bar[XB_TOPGEN], 1u);
            else XB_SPIN(xb_ld(&bar[XB_TOPGEN]) == tg, bar);
            __builtin_amdgcn_fence(__ATOMIC_ACQUIRE, "agent");
            xb_add(&bar[XB_XGEN(b.x)], 1u);
            asm volatile("s_waitcnt vmcnt(0)" ::: "memory");
        } else {
            XB_SPIN(xb_ld(&bar[XB_XGEN(b.x)]) == gen, bar);
            __builtin_amdgcn_fence(__ATOMIC_ACQUIRE, "agent");
            asm volatile("s_waitcnt vmcnt(0)" ::: "memory");
        }
    }
    __syncthreads();
}


typedef unsigned short bf16;
typedef short bf16x8 __attribute__((ext_vector_type(8)));
typedef float f32x4 __attribute__((ext_vector_type(4)));
typedef unsigned u32x4 __attribute__((ext_vector_type(4)));
typedef unsigned u32x2 __attribute__((ext_vector_type(2)));
#define GAS __attribute__((address_space(1)))
#define DI __device__ __forceinline__

constexpr int BATCH = 4, SEQ = 4096, D = 1024, DEPTH = 2;
constexpr int M = BATCH * SEQ;
constexpr int NIN = 4352, FF = 4096, PLE = 256;
constexpr int NQKV = 2304, NGATE = 2048;
constexpr float EPS = 1e-6f;
constexpr float LOG2E = 1.4426950408889634f;
constexpr float C2 = 0.125f * LOG2E;
constexpr int NWAVES = 8;

constexpr size_t MiB = 1u << 20;
constexpr size_t WS_CTL = 0, CTL_ZERO_BYTES = 64 * 1024;
constexpr size_t WS_WIN = 1 * MiB;
constexpr size_t WS_WUP = WS_WIN + (size_t)NIN * D * 2;
constexpr size_t WS_WO = WS_WUP + 2 * MiB;
constexpr size_t WS_WFF1 = WS_WO + 2 * MiB;
constexpr size_t WS_WFF2 = WS_WFF1 + 8 * MiB;
constexpr size_t WS_WPE = WS_WFF2 + 8 * MiB;
constexpr size_t WS_WPG = WS_WPE + MiB / 2;
constexpr size_t WS_SS = 32 * MiB;
constexpr size_t WS_BT = 33 * MiB;
constexpr size_t WS_PB = 34 * MiB;
constexpr size_t WS_XB = 50 * MiB;
constexpr size_t WS_ATT = 82 * MiB;
constexpr size_t WS_QKV = 114 * MiB;
constexpr size_t WS_GATE = 186 * MiB;
constexpr size_t WS_MRG = WS_QKV;
constexpr size_t WS_U = WS_QKV;
constexpr size_t WS_PE = WS_ATT;
constexpr size_t WS_END = 250 * MiB;
static_assert(WS_WPG + 2 * MiB <= WS_SS && WS_U + (size_t)M * FF * 2 <= WS_END && WS_GATE + (size_t)M * NGATE * 2 <= WS_END, "ws map");
constexpr int CW_BAR = 4096;

constexpr int RING_BYTES = 131072;
constexpr int MISC_OFF = RING_BYTES + 320;
constexpr int LDS_BYTES = 147456;

DI unsigned f2bf(float f) { unsigned u = __builtin_bit_cast(unsigned, f); return (u + 0x7fffu + ((u >> 16) & 1u)) >> 16; }
DI unsigned pk2(float lo, float hi) { return f2bf(lo) | (f2bf(hi) << 16); }
typedef float f32x2_t __attribute__((ext_vector_type(2))); typedef __bf16 bf16x2_t __attribute__((ext_vector_type(2)));
DI unsigned cvtpk(float lo, float hi) { f32x2_t v = {lo, hi}; bf16x2_t b = __builtin_convertvector(v, bf16x2_t); return __builtin_bit_cast(unsigned, b); }
DI u32x4 pack8(f32x4 a, f32x4 b) { u32x4 w; w.x = cvtpk(a[0], a[1]); w.y = cvtpk(a[2], a[3]); w.z = cvtpk(b[0], b[1]); w.w = cvtpk(b[2], b[3]); return w; }
DI void unpack8(u32x4 w, f32x4& a, f32x4& b) {
    a = (f32x4){__builtin_bit_cast(float, w.x << 16), __builtin_bit_cast(float, w.x & 0xffff0000u), __builtin_bit_cast(float, w.y << 16), __builtin_bit_cast(float, w.y & 0xffff0000u)};
    b = (f32x4){__builtin_bit_cast(float, w.z << 16), __builtin_bit_cast(float, w.z & 0xffff0000u), __builtin_bit_cast(float, w.w << 16), __builtin_bit_cast(float, w.w & 0xffff0000u)}; }
template <int X> DI float swz_xor(float v) { return __builtin_bit_cast(float, __builtin_amdgcn_ds_swizzle(__builtin_bit_cast(int, v), (X << 10) | 0x1f)); }
DI float sum_halves(float v) { auto rr = __builtin_amdgcn_permlane32_swap(__float_as_uint(v), __float_as_uint(v), false, false); return __uint_as_float(rr[0]) + __uint_as_float(rr[1]); }
DI float wave_sum(float v) { v += swz_xor<1>(v); v += swz_xor<2>(v); v += swz_xor<4>(v); v += swz_xor<8>(v); v += swz_xor<16>(v); return sum_halves(v); }
constexpr int RS_TAB_OFF = RING_BYTES + 8192;
typedef __amdgpu_buffer_rsrc_t rsrc_t;
DI rsrc_t mk_rsrc(const void* base, size_t bytes) { return __builtin_amdgcn_make_buffer_rsrc((void*)base, (short)0, (int)bytes, 0x00020000); }
DI void st16(rsrc_t r, size_t byte_off, u32x4 v) { __builtin_amdgcn_raw_buffer_store_b128(v, r, (unsigned)byte_off, 0,   16); }
DI float rs_from(f32x4 s) { return 1.0f / sqrtf(((s[0] + s[1]) + (s[2] + s[3])) * (1.0f / D) + EPS); }
DI float sigm(float v) { return 1.0f / (1.0f + __expf(-v)); }
#define MEMFENCE() asm volatile("" ::: "memory")

using pg8::Unit;
constexpr int HALF = 128;
DI void load_rs8(const float* SS, int row0, float (&rs)[2][4]) {
    f32x4 s[2][4];
#pragma unroll
    for (int ai = 0; ai < 2; ++ai)
#pragma unroll
        for (int m = 0; m < 4; ++m) s[ai][m] = *(const f32x4*)(SS + (size_t)(row0 + ai * HALF + m * 16) * 4);
#pragma unroll
    for (int ai = 0; ai < 2; ++ai)
#pragma unroll
        for (int m = 0; m < 4; ++m) rs[ai][m] = rs_from(s[ai][m]);
}

DI void load_rs8_tab(LAS unsigned char* lds, int idx, int wr, int fr, float (&rs)[2][4]) {
    const LAS float* t = (const LAS float*)(lds + RS_TAB_OFF) + idx * 256 + wr * 64 + fr;
#pragma unroll
    for (int ai = 0; ai < 2; ++ai)
#pragma unroll
        for (int m = 0; m < 4; ++m) rs[ai][m] = t[ai * HALF + m * 16];
}
template <class Sched> DI void rs_table_fill(LAS unsigned char* lds, const float* SS, const Sched& S, int tid) {
    LAS float* t = (LAS float*)(lds + RS_TAB_OFF);
    Unit u;
    for (int i = 0; i < 6 && S.next(i, u); ++i) if (tid < 256) t[i * 256 + tid] = rs_from(*(const f32x4*)(SS + (size_t)(u.pm * 256 + tid) * 4));
    __syncthreads();
}
struct EpiIn {
    static constexpr bool PERM = true, AFTER_DRAIN = false, MIDSCALE = false;
    LAS unsigned char* lds; rsrc_t QKV; rsrc_t GATE;
    DI void operator()(const f32x4 (&acc)[2][2][4][2], const Unit& u, int wr, int wc, int fr, int fq) const {
        const int row0 = u.pm * 256 + wr * 64 + fr;
        float rs[2][4]; load_rs8_tab(lds, u.idx, wr, fr, rs);
        if (u.pn < 9) {
            const float cs = (u.pn < 2 || u.pn == 6 || u.pn == 7) ? C2 : 1.0f;
            const int col0 = u.pn * 256 + wc * 32 + 8 * fq;
#pragma unroll
            for (int ai = 0; ai < 2; ++ai)
#pragma unroll
                for (int m = 0; m < 4; ++m) { const float sc = rs[ai][m] * cs; const size_t ro = ((size_t)(row0 + ai * HALF + m * 16) * NQKV + col0) * 2;
#pragma unroll
                    for (int bj = 0; bj < 2; ++bj) st16(QKV, ro + bj * HALF * 2, pack8(acc[ai][bj][m][0] * sc, acc[ai][bj][m][1] * sc)); }
        } else {
            const int c0 = (u.pn - 9) * 128 + wc * 32 + 8 * fq;
#pragma unroll
            for (int ai = 0; ai < 2; ++ai)
#pragma unroll
                for (int m = 0; m < 4; ++m) { const float r = rs[ai][m]; const size_t ro = ((size_t)(row0 + ai * HALF + m * 16) * NGATE + c0) * 2;
                    f32x4 ra[2], gb[2];
#pragma unroll
                    for (int n = 0; n < 2; ++n)
#pragma unroll
                        for (int j = 0; j < 4; ++j) { const float ea = fminf(__expf(-acc[ai][0][m][n][j] * r), 1e30f), eb = fminf(__expf(-acc[ai][1][m][n][j] * r), 1e30f);
                            const float g = 1.0f / (1.0f + eb); gb[n][j] = g; ra[n][j] = (1.0f + eb) / (1.0f + ea); }
                    st16(GATE, ro, pack8(ra[0], ra[1])); st16(GATE, ro + 2048, pack8(gb[0], gb[1])); }
        }
    }
};
struct EpiUp {
    static constexpr bool PERM = true, AFTER_DRAIN = false, MIDSCALE = true;
    const bf16* GATE; rsrc_t MRG;
    DI void mid(f32x4 (&acc)[2][2][4][2], const Unit& u, int wr, int wc, int fr, int fq) const {
        const int row0 = u.pm * 256 + wr * 64 + fr, col0 = u.pn * 256 + wc * 32 + 8 * fq;
#pragma unroll
        for (int ai = 0; ai < 2; ++ai) { u32x4 gv[4][2];
#pragma unroll
            for (int m = 0; m < 4; ++m)
#pragma unroll
                for (int bj = 0; bj < 2; ++bj) gv[m][bj] = *(const u32x4*)(GATE + (size_t)(row0 + ai * HALF + m * 16) * NGATE + col0 + bj * HALF);
#pragma unroll
            for (int m = 0; m < 4; ++m)
#pragma unroll
                for (int bj = 0; bj < 2; ++bj) { f32x4 a, b; unpack8(gv[m][bj], a, b); acc[ai][bj][m][0] *= a; acc[ai][bj][m][1] *= b; }
            MEMFENCE(); }
    }
    DI void operator()(const f32x4 (&acc)[2][2][4][2], const Unit& u, int wr, int wc, int fr, int fq) const {
        const int row0 = u.pm * 256 + wr * 64 + fr, col0 = u.pn * 256 + wc * 32 + 8 * fq;
#pragma unroll
        for (int ai = 0; ai < 2; ++ai) { u32x4 gv[4][2];
#pragma unroll
            for (int m = 0; m < 4; ++m)
#pragma unroll
                for (int bj = 0; bj < 2; ++bj) gv[m][bj] = *(const u32x4*)(GATE + (size_t)(row0 + ai * HALF + m * 16) * NGATE + 1024 + col0 + bj * HALF);
#pragma unroll
            for (int m = 0; m < 4; ++m)
#pragma unroll
                for (int bj = 0; bj < 2; ++bj) { f32x4 a, b; unpack8(gv[m][bj], a, b);
                    st16(MRG, ((size_t)(row0 + ai * HALF + m * 16) * D + col0 + bj * HALF) * 2, pack8(acc[ai][bj][m][0] * a, acc[ai][bj][m][1] * b)); }
            MEMFENCE(); }
    }
};
struct EpiFf1 {
    static constexpr bool PERM = true, AFTER_DRAIN = false, MIDSCALE = false;
    LAS unsigned char* lds; rsrc_t U;
    DI void operator()(const f32x4 (&acc)[2][2][4][2], const Unit& u, int wr, int wc, int fr, int fq) const {
        const int row0 = u.pm * 256 + wr * 64 + fr, col0 = u.pn * 256 + wc * 32 + 8 * fq;
        float rs[2][4]; load_rs8_tab(lds, u.idx, wr, fr, rs);
#pragma unroll
        for (int ai = 0; ai < 2; ++ai)
#pragma unroll
            for (int m = 0; m < 4; ++m) { const float r = rs[ai][m]; const size_t ro = ((size_t)(row0 + ai * HALF + m * 16) * FF + col0) * 2;
#pragma unroll
                for (int bj = 0; bj < 2; ++bj) { f32x4 v0 = acc[ai][bj][m][0] * r, v1 = acc[ai][bj][m][1] * r;
#pragma unroll
                    for (int j = 0; j < 4; ++j) { const float a = fmaxf(v0[j], 0.f), b = fmaxf(v1[j], 0.f); v0[j] = a * a; v1[j] = b * b; }
                    st16(U, ro + bj * HALF * 2, pack8(v0, v1)); } }
    }
};
struct EpiPe {
    static constexpr bool PERM = true, AFTER_DRAIN = false, MIDSCALE = false;
    rsrc_t PE;
    DI void operator()(const f32x4 (&acc)[2][2][4][2], const Unit& u, int wr, int wc, int fr, int fq) const {
        const int row0 = u.pm * 256 + wr * 64 + fr, col0 = u.pn * 256 + wc * 32 + 8 * fq;
#pragma unroll
        for (int ai = 0; ai < 2; ++ai)
#pragma unroll
            for (int m = 0; m < 4; ++m) { const size_t ro = ((size_t)(row0 + ai * HALF + m * 16) * D + col0) * 2;
#pragma unroll
                for (int bj = 0; bj < 2; ++bj) st16(PE, ro + bj * HALF * 2, pack8(acc[ai][bj][m][0], acc[ai][bj][m][1])); }
    }
};
template <bool GATED, bool XF32> struct EpiRes {
    static constexpr bool PERM = true, AFTER_DRAIN = true, MIDSCALE = false;
    const float* xin32; const bf16* xin16; rsrc_t XBout; float* SS; const bf16* PE; const float* SSr; bool dry; XcdBarrier bar;
    DI void fused(f32x4 (&acc)[2][2][4][2], const Unit& u, int wr, int wc, int fr, int fq, LAS unsigned char* lds, int wid, int lane) const {
        const int row0 = u.pm * 256 + wr * 64 + fr, col0 = u.pn * 256 + wc * 32 + 8 * fq;
        LAS float* P = (LAS float*)lds;
        float rs[2][4];
        if (GATED) { load_rs8(SSr, row0, rs); xcd_barrier(bar, wid == 0 && lane == 0); }
#pragma unroll
        for (int ai = 0; ai < 2; ++ai) {
            u32x4 xv[4][2]; f32x4 xf[XF32 ? 4 : 1][2][2]; u32x4 pv_[GATED ? 4 : 1][2];
#pragma unroll
            for (int m = 0; m < 4; ++m)
#pragma unroll
                for (int bj = 0; bj < 2; ++bj) { const size_t o = (size_t)(row0 + ai * HALF + m * 16) * D + col0 + bj * HALF;
                    if (XF32) { xf[XF32 ? m : 0][bj][0] = *(const f32x4*)(xin32 + o); xf[XF32 ? m : 0][bj][1] = *(const f32x4*)(xin32 + o + 4); } else xv[m][bj] = *(const u32x4*)(xin16 + o);
                    if (GATED) pv_[GATED ? m : 0][bj] = *(const u32x4*)(PE + o); }
#pragma unroll
            for (int m = 0; m < 4; ++m) { const size_t r = (size_t)(row0 + ai * HALF + m * 16); float ss = 0.f;
#pragma unroll
                for (int bj = 0; bj < 2; ++bj) { const size_t o = r * D + col0 + bj * HALF;
                    f32x4 x0, x1, v0 = acc[ai][bj][m][0], v1 = acc[ai][bj][m][1];
                    if (XF32) { x0 = xf[XF32 ? m : 0][bj][0]; x1 = xf[XF32 ? m : 0][bj][1]; } else unpack8(xv[m][bj], x0, x1);
                    if (GATED) { f32x4 p0, p1; unpack8(pv_[GATED ? m : 0][bj], p0, p1); const float rr = rs[ai][m];
#pragma unroll
                        for (int j = 0; j < 4; ++j) { v0[j] = p0[j] * sigm(v0[j] * rr); v1[j] = p1[j] * sigm(v1[j] * rr); } }
                    x0 += v0; x1 += v1;
                    if (!dry) st16(XBout, o * 2, pack8(x0, x1));
                    ss += ((x0[0] * x0[0] + x0[1] * x0[1]) + (x0[2] * x0[2] + x0[3] * x0[3])) + ((x1[0] * x1[0] + x1[1] * x1[1]) + (x1[2] * x1[2] + x1[3] * x1[3])); }
                ss += swz_xor<16>(ss); ss = sum_halves(ss);
                if (fq == 0) P[(ai * HALF + wr * 64 + m * 16 + fr) * 4 + wc] = ss; }
            MEMFENCE(); }
        __syncthreads();
        if (wid < 4 && !dry) { const int row = wid * 64 + lane; const f32x4 p = *(const LAS f32x4*)(P + row * 4);
            SS[(size_t)(u.pm * 256 + row) * 4 + u.pn] = (p[0] + p[1]) + (p[2] + p[3]); }
        __syncthreads();
    }
};


namespace att {
typedef short s16x4 __attribute__((ext_vector_type(4)));
typedef float f32x16 __attribute__((ext_vector_type(16)));
typedef LAS const char* lds_cptr;
#define SBAR() __builtin_amdgcn_sched_barrier(0)
#define MFMA32(a, b, c) __builtin_amdgcn_mfma_f32_32x32x16_bf16((a), (b), (c), 0, 0, 0)
DI int crow(int r, int hi) { return (r & 3) + 8 * (r >> 2) + 4 * hi; }
DI void qkt(f32x16& p0, f32x16& p1, lds_cptr Kslot, const bf16x8* qr, int r32, int hi) {
    const lds_cptr kb = Kslot + hi * 1024 + r32 * 16;
    f32x16 z0 = {}, z1 = {};
#pragma unroll
    for (int d0 = 0; d0 < 4; ++d0) {
        const bf16x8 b0 = *(const LAS bf16x8*)(kb + d0 * 2048), b1 = *(const LAS bf16x8*)(kb + d0 * 2048 + 512);
        z0 = MFMA32(b0, qr[d0], z0); z1 = MFMA32(b1, qr[d0], z1); }
    p0 = z0; p1 = z1;
}
DI void pv(f32x16* o, int vb, bf16x8 pa0, bf16x8 pa1, bf16x8 pa2, bf16x8 pa3) {
#pragma unroll
    for (int d0 = 0; d0 < 2; ++d0) { s16x4 lo[4], hi[4];
#pragma unroll
        for (int ks = 0; ks < 4; ++ks) {
            asm volatile("ds_read_b64_tr_b16 %0,%1 offset:%c2" : "=&v"(lo[ks]) : "v"(vb), "i"(d0 * 4096 + ks * 1024) : "memory");
            asm volatile("ds_read_b64_tr_b16 %0,%1 offset:%c2" : "=&v"(hi[ks]) : "v"(vb), "i"(d0 * 4096 + ks * 1024 + 512) : "memory"); }
        asm volatile("s_waitcnt lgkmcnt(0)" ::: "memory"); SBAR();
#define PK(k) (bf16x8){lo[k][0], lo[k][1], lo[k][2], lo[k][3], hi[k][0], hi[k][1], hi[k][2], hi[k][3]}
        o[d0] = MFMA32(pa0, PK(0), o[d0]); o[d0] = MFMA32(pa1, PK(1), o[d0]); o[d0] = MFMA32(pa2, PK(2), o[d0]); o[d0] = MFMA32(pa3, PK(3), o[d0]);
#undef PK
    }
}
DI int vlane_ofs(int lane, int hi) { return ((lane >> 4) & 1) * 32 + (lane & 3) * 8 + (4 * hi + ((lane & 15) >> 2)) * 64; }
DI float other_half(float v, int hi) { auto rr = __builtin_amdgcn_permlane32_swap(__float_as_uint(v), __float_as_uint(v), false, false); return __uint_as_float(hi ? rr[0] : rr[1]); }
DI void pack_p(const f32x16& p0, const f32x16& p1, u32x4& w0, u32x4& w1, u32x4& w2, u32x4& w3) {
    w0 = (u32x4){cvtpk(p0[0], p0[1]), cvtpk(p0[2], p0[3]), cvtpk(p0[4], p0[5]), cvtpk(p0[6], p0[7])};
    w1 = (u32x4){cvtpk(p0[8], p0[9]), cvtpk(p0[10], p0[11]), cvtpk(p0[12], p0[13]), cvtpk(p0[14], p0[15])};
    w2 = (u32x4){cvtpk(p1[0], p1[1]), cvtpk(p1[2], p1[3]), cvtpk(p1[4], p1[5]), cvtpk(p1[6], p1[7])};
    w3 = (u32x4){cvtpk(p1[8], p1[9]), cvtpk(p1[10], p1[11]), cvtpk(p1[12], p1[13]), cvtpk(p1[14], p1[15])};
}
DI void store_o(const f32x16* o, const float* scale, LAS bf16* stg, rsrc_t Ob, size_t obase  , int pitch, int lane, int r32, int hi) {
#pragma unroll
    for (int r = 0; r < 16; ++r) { const int orow = crow(r, hi); const float sc = scale ? scale[r] : 1.0f;
#pragma unroll
        for (int d0 = 0; d0 < 2; ++d0) stg[orow * 64 + d0 * 32 + r32] = (bf16)f2bf(o[d0][r] * sc); }
    asm volatile("s_waitcnt lgkmcnt(0)" ::: "memory");
#pragma unroll
    for (int i = 0; i < 4; ++i) { const int row = i * 8 + (lane >> 3), ch = lane & 7; const u32x4 v = *(const LAS u32x4*)(stg + row * 64 + ch * 8); st16(Ob, (obase + (size_t)row * pitch + ch * 8) * 2, v); }
}

DI void sb_half(f32x16& p, float& T, int kb, int qabs, bool need_mask, int hi) {
    f32x16 bt;
#pragma unroll
    for (int r = 0; r < 16; ++r) { const float e = __builtin_fminf(__builtin_amdgcn_exp2f(-p[r]), 1.8446744e19f), b = __builtin_amdgcn_rcpf(1.0f + e); bt[r] = b; p[r] = e * b; }
    if (need_mask) {
#pragma unroll
        for (int r = 0; r < 16; ++r) { const int key = kb + (r & 3) + 8 * (r >> 2); if (key >= qabs) { p[r] = 1.0f; bt[r] = 0.f; } } }
    float gp[4], og[4];
#pragma unroll
    for (int g = 0; g < 4; ++g) gp[g] = (p[4 * g] * p[4 * g + 1]) * (p[4 * g + 2] * p[4 * g + 3]);
#pragma unroll
    for (int g = 0; g < 4; ++g) og[g] = other_half(gp[g], hi);
#pragma unroll
    for (int g = 3; g >= 0; --g) { float S = T * (hi ? 1.0f : og[g]); T *= gp[g] * og[g];
        const float a3 = bt[4 * g + 3] * S; S *= p[4 * g + 3];
        const float a2 = bt[4 * g + 2] * S; S *= p[4 * g + 2];
        const float a1 = bt[4 * g + 1] * S; S *= p[4 * g + 1];
        const float a0 = bt[4 * g] * S;
        p[4 * g] = a0; p[4 * g + 1] = a1; p[4 * g + 2] = a2; p[4 * g + 3] = a3; }
}
DI void sb_tile(f32x16& p1, f32x16& p0, float& T, int kb, int qabs, bool need_mask, int hi) {
    f32x16 b1, b0;
#pragma unroll
    for (int r = 0; r < 16; ++r) {
        { const float e = __builtin_fminf(__builtin_amdgcn_exp2f(-p1[r]), 1.8446744e19f), b = __builtin_amdgcn_rcpf(1.0f + e); b1[r] = b; p1[r] = e * b; }
        { const float e = __builtin_fminf(__builtin_amdgcn_exp2f(-p0[r]), 1.8446744e19f), b = __builtin_amdgcn_rcpf(1.0f + e); b0[r] = b; p0[r] = e * b; } }
    if (need_mask) {
#pragma unroll
        for (int r = 0; r < 16; ++r) { const int key = kb + (r & 3) + 8 * (r >> 2);
            if (key + 32 >= qabs) { p1[r] = 1.0f; b1[r] = 0.f; }
            if (key >= qabs) { p0[r] = 1.0f; b0[r] = 0.f; } } }
    float gp1[4], gp0[4], og1[4], og0[4];
#pragma unroll
    for (int g = 0; g < 4; ++g) { gp1[g] = (p1[4 * g] * p1[4 * g + 1]) * (p1[4 * g + 2] * p1[4 * g + 3]); gp0[g] = (p0[4 * g] * p0[4 * g + 1]) * (p0[4 * g + 2] * p0[4 * g + 3]); }
#pragma unroll
    for (int g = 0; g < 4; ++g) { og1[g] = other_half(gp1[g], hi); og0[g] = other_half(gp0[g], hi); }
#pragma unroll
    for (int g = 3; g >= 0; --g) { float S = T * (hi ? 1.0f : og1[g]); T *= gp1[g] * og1[g];
        const float a3 = b1[4 * g + 3] * S; S *= p1[4 * g + 3];
        const float a2 = b1[4 * g + 2] * S; S *= p1[4 * g + 2];
        const float a1 = b1[4 * g + 1] * S; S *= p1[4 * g + 1];
        const float a0 = b1[4 * g] * S;
        p1[4 * g] = a0; p1[4 * g + 1] = a1; p1[4 * g + 2] = a2; p1[4 * g + 3] = a3; }
#pragma unroll
    for (int g = 3; g >= 0; --g) { float S = T * (hi ? 1.0f : og0[g]); T *= gp0[g] * og0[g];
        const float a3 = b0[4 * g + 3] * S; S *= p0[4 * g + 3];
        const float a2 = b0[4 * g + 2] * S; S *= p0[4 * g + 2];
        const float a1 = b0[4 * g + 1] * S; S *= p0[4 * g + 1];
        const float a0 = b0[4 * g] * S;
        p0[4 * g] = a0; p0[4 * g + 1] = a1; p0[4 * g + 2] = a2; p0[4 * g + 3] = a3; }
}
DI void load_k(bf16x8 (&kf)[8], const bf16* ksrc, int jt) {
    const bf16* p = ksrc + (long)jt * 64 * NQKV;
#pragma unroll
    for (int d0 = 0; d0 < 4; ++d0) { kf[2 * d0] = *(const bf16x8*)(p + 16 * d0); kf[2 * d0 + 1] = *(const bf16x8*)(p + (long)32 * NQKV + 16 * d0); }
}
DI void dma_v(const bf16* vsrc, int jt, LAS char* slot) {
    const bf16* p = vsrc + (long)jt * 64 * NQKV;
#pragma unroll
    for (int i = 0; i < 8; ++i) __builtin_amdgcn_global_load_lds((const GAS unsigned*)(p + (long)(16 * (i & 3)) * NQKV + 32 * (i >> 2)), (LAS unsigned*)(slot + i * 1024), 16, 0, 0);
}
DI void load_v(u32x4 (&vr)[8], const bf16* vsrc, int jt) {
    const bf16* p = vsrc + (long)jt * 64 * NQKV;
#pragma unroll
    for (int i = 0; i < 8; ++i) vr[i] = *(const u32x4*)(p + (long)(16 * (i & 3)) * NQKV + 32 * (i >> 2));
}
DI void store_v(const u32x4 (&vr)[8], LAS char* slot, int lane) {
#pragma unroll
    for (int i = 0; i < 8; ++i) *(LAS u32x4*)(slot + i * 1024 + lane * 16) = vr[i];
}
template <int KB> DI f32x16 qkt_h(const bf16x8 (&kf)[8], const bf16x8* qr) {
    f32x16 z = {};
#pragma unroll
    for (int d0 = 0; d0 < 4; ++d0) z = MFMA32(kf[2 * d0 + KB], qr[d0], z);
    return z;
}
template <int KB> DI void pv_h(f32x16* o, int vb, const f32x16& p) {
    const u32x4 w0 = (u32x4){cvtpk(p[0], p[1]), cvtpk(p[2], p[3]), cvtpk(p[4], p[5]), cvtpk(p[6], p[7])}, w1 = (u32x4){cvtpk(p[8], p[9]), cvtpk(p[10], p[11]), cvtpk(p[12], p[13]), cvtpk(p[14], p[15])};
    s16x4 lo[4], hi[4];
#pragma unroll
    for (int d0 = 0; d0 < 2; ++d0)
#pragma unroll
        for (int ks = 0; ks < 2; ++ks) {
            asm volatile("ds_read_b64_tr_b16 %0,%1 offset:%c2" : "=&v"(lo[2 * d0 + ks]) : "v"(vb), "i"(d0 * 4096 + (2 * KB + ks) * 1024) : "memory");
            asm volatile("ds_read_b64_tr_b16 %0,%1 offset:%c2" : "=&v"(hi[2 * d0 + ks]) : "v"(vb), "i"(d0 * 4096 + (2 * KB + ks) * 1024 + 512) : "memory"); }
    asm volatile("s_waitcnt lgkmcnt(0)" ::: "memory"); SBAR();
#define PK(k) (bf16x8){lo[k][0], lo[k][1], lo[k][2], lo[k][3], hi[k][0], hi[k][1], hi[k][2], hi[k][3]}
    o[0] = MFMA32(__builtin_bit_cast(bf16x8, w0), PK(0), o[0]); o[0] = MFMA32(__builtin_bit_cast(bf16x8, w1), PK(1), o[0]);
    o[1] = MFMA32(__builtin_bit_cast(bf16x8, w0), PK(2), o[1]); o[1] = MFMA32(__builtin_bit_cast(bf16x8, w1), PK(3), o[1]);
#undef PK
}
DI void load_rows(u32x4 (&r)[8], const bf16* src, int jt) {
    const bf16* p = src + (long)jt * 64 * NQKV;
#pragma unroll
    for (int i = 0; i < 8; ++i) r[i] = *(const u32x4*)(p + (long)(8 * i) * NQKV);
}
DI void store_k_img(const u32x4 (&r)[8], LAS char* img, int lane) {
#pragma unroll
    for (int i = 0; i < 8; ++i) *(LAS u32x4*)(img + (lane & 7) * 1024 + (8 * i + (lane >> 3)) * 16) = r[i];
}
DI void store_v_img(const u32x4 (&r)[8], LAS char* img, int lane) {
#pragma unroll
    for (int i = 0; i < 8; ++i) { const int key = 8 * i + (lane >> 3), c = lane & 7; *(LAS u32x4*)(img + (c >> 2) * 4096 + (key >> 4) * 1024 + (key & 15) * 64 + (c & 3) * 16) = r[i]; }
}
template <int KB> DI f32x16 qkt_l(lds_cptr kimg, const bf16x8* qr, int r32, int hi) {
    const lds_cptr kb = kimg + hi * 1024 + KB * 512 + r32 * 16;
    f32x16 z = {};
#pragma unroll
    for (int d0 = 0; d0 < 4; ++d0) z = MFMA32(*(const LAS bf16x8*)(kb + d0 * 2048), qr[d0], z);
    return z;
}
template <bool EARLY> DI void sbw_unit(int b, int h, int qb32, const bf16* QKV, rsrc_t ATT, LAS char* wl, int lane) {
    const int r32 = lane & 31, hi = lane >> 5;
    const long rowbase = (long)b * SEQ; const int qs = qb32 * 32, qabs = qs + r32;
    const bf16* Qw = QKV + (rowbase + qs) * NQKV + h * 64;
    const bf16* ksrc = QKV + rowbase * NQKV + 512 + h * 64 + (long)(lane >> 3) * NQKV + (lane & 7) * 8;
    const bf16* vsrc = ksrc + 512;
    bf16x8 qr[4];
#pragma unroll
    for (int d0 = 0; d0 < 4; ++d0) qr[d0] = *(const bf16x8*)(Qw + (long)r32 * NQKV + d0 * 16 + hi * 8);
    f32x16 o[2]; o[0] = f32x16{}; o[1] = f32x16{};
    float T = 1.0f;
    int jt = (qs + 31) >> 6;
    LAS char* kimg = wl; LAS char* vimg = wl + 8192;
    const int vofs = (int)(uintptr_t)vimg + vlane_ofs(lane, hi);
    u32x4 kr[8], vr[8];
    load_rows(kr, ksrc, jt); load_rows(vr, vsrc, jt);
    for (;;) {
        store_k_img(kr, kimg, lane); store_v_img(vr, vimg, lane);
        if (jt > 0) { load_rows(kr, ksrc, jt - 1); load_rows(vr, vsrc, jt - 1); }
        f32x16 p1, p0;
        { const lds_cptr kb1 = (lds_cptr)kimg + hi * 1024 + 512 + r32 * 16, kb0 = (lds_cptr)kimg + hi * 1024 + r32 * 16; f32x16 z1 = {}, z0 = {};
#pragma unroll
          for (int d0 = 0; d0 < 4; ++d0) { z1 = MFMA32(*(const LAS bf16x8*)(kb1 + d0 * 2048), qr[d0], z1); z0 = MFMA32(*(const LAS bf16x8*)(kb0 + d0 * 2048), qr[d0], z0); }
          p1 = z1; p0 = z0; }
        sb_tile(p1, p0, T, 64 * jt + 4 * hi, qabs, 64 * jt + 63 >= qs, hi);
        u32x4 w0, w1, w2, w3; pack_p(p0, p1, w0, w1, w2, w3);
        pv(o, vofs, __builtin_bit_cast(bf16x8, w0), __builtin_bit_cast(bf16x8, w1), __builtin_bit_cast(bf16x8, w2), __builtin_bit_cast(bf16x8, w3));
        bool done = false;
        if (EARLY) done = __all(T == 0.0f) != 0;
        if (done || jt == 0) break;
        --jt;
    }
    asm volatile("s_waitcnt lgkmcnt(0)" ::: "memory");
    store_o(o, nullptr, (LAS bf16*)wl, ATT, (size_t)(rowbase + qs) * D + h * 64, D, lane, r32, hi);
    asm volatile("s_waitcnt lgkmcnt(0)" ::: "memory");
}

template <int KB> DI void swa_scores(f32x16& s, const bf16x8 (&kf)[8], const bf16x8* qr, const LAS float* btl, int db  , float& m) {
    s = qkt_h<KB>(kf, qr);
#pragma unroll
    for (int r = 0; r < 16; ++r) { const int d_ = db - ((r & 3) + 8 * (r >> 2)); const float v = s[r] + btl[d_ & 127]; s[r] = (unsigned)d_ < 128u ? v : -INFINITY; m = __builtin_fmaxf(m, s[r]); }
}
template <int KB> DI void swa_pv(f32x16& s, float m, float& l, f32x16* o, int vb) {
#pragma unroll
    for (int r = 0; r < 16; ++r) { s[r] = __builtin_amdgcn_exp2f(s[r] - m); l += s[r]; }
    pv_h<KB>(o, vb, s);
}
DI void swaw_unit(int b, int h, int qb32, int layer, const bf16* QKV, const float* BT, rsrc_t ATT, LAS char* wl, LAS float* btl, LAS float* wsf, int lane) {
    const int r32 = lane & 31, hi = lane >> 5, kvh = h >> 2;
    const long rowbase = (long)b * SEQ; const int qs = qb32 * 32, qabs = qs + r32;
    const bf16* Qw = QKV + (rowbase + qs) * NQKV + 1536 + h * 64;
    const bf16* ksrc = QKV + rowbase * NQKV + 2048 + kvh * 64 + (long)r32 * NQKV + hi * 8;
    const bf16* vsrc = QKV + rowbase * NQKV + 2176 + kvh * 64 + (long)(lane >> 2) * NQKV + (lane & 3) * 8;
    const int jlo = (qs - 127) >> 6;
    const bool odd = (qs & 32) != 0;
    const bool t0 = jlo >= 0, t1 = jlo + 1 >= 0;
    bf16x8 kA[8], kB[8];
    if (t0) load_k(kA, ksrc, jlo);
    if (t1) load_k(kB, ksrc, jlo + 1);
    if (t0) dma_v(vsrc, jlo, wl);
    if (t1) dma_v(vsrc, jlo + 1, wl + 8192);
    btl[lane] = BT[h * 128 + lane]; btl[64 + lane] = BT[h * 128 + 64 + lane];
    const float sink = BT[1024 + layer * 8 + h];
    bf16x8 qr[4];
#pragma unroll
    for (int d0 = 0; d0 < 4; ++d0) qr[d0] = *(const bf16x8*)(Qw + (long)r32 * NQKV + d0 * 16 + hi * 8);
    const int vofs = (int)(uintptr_t)wl + vlane_ofs(lane, hi);
    asm volatile("s_waitcnt lgkmcnt(0)" ::: "memory");
    const int db0 = qabs - (64 * jlo + 4 * hi);
    f32x16 s00, s01, s10, s11, s20, s21;
    float m = sink;
    if (t0) { if (!odd) swa_scores<0>(s00, kA, qr, btl, db0, m); swa_scores<1>(s01, kA, qr, btl, db0 - 32, m); }
    load_k(kA, ksrc, jlo + 2);
    if (t1) { swa_scores<0>(s10, kB, qr, btl, db0 - 64, m); swa_scores<1>(s11, kB, qr, btl, db0 - 96, m); }
    swa_scores<0>(s20, kA, qr, btl, db0 - 128, m); if (odd) swa_scores<1>(s21, kA, qr, btl, db0 - 160, m);
    m = __builtin_fmaxf(m, other_half(m, hi));
    f32x16 o[2]; o[0] = f32x16{}; o[1] = f32x16{};
    float l = 0.f;
    asm volatile("s_waitcnt vmcnt(0)" ::: "memory");
    if (t0) { if (!odd) swa_pv<0>(s00, m, l, o, vofs); swa_pv<1>(s01, m, l, o, vofs); }
    dma_v(vsrc, jlo + 2, wl);
    if (t1) { swa_pv<0>(s10, m, l, o, vofs + 8192); swa_pv<1>(s11, m, l, o, vofs + 8192); }
    asm volatile("s_waitcnt vmcnt(0)" ::: "memory");
    swa_pv<0>(s20, m, l, o, vofs); if (odd) swa_pv<1>(s21, m, l, o, vofs);
    l += other_half(l, hi); l += __builtin_amdgcn_exp2f(sink - m);
    if (hi == 0) wsf[r32] = 1.0f / l;
    asm volatile("s_waitcnt lgkmcnt(0)" ::: "memory");
    float rli[16];
#pragma unroll
    for (int r = 0; r < 16; ++r) rli[r] = wsf[crow(r, hi)];
    store_o(o, rli, (LAS bf16*)wl, ATT, (size_t)(rowbase + qs) * D + 512 + h * 64, D, lane, r32, hi);
    asm volatile("s_waitcnt lgkmcnt(0)" ::: "memory");
}
#undef SBAR
#undef MFMA32
}


DI void conv_w(const float* W, const float* g, bf16* WT, int K, int N, int ldk, int koff, bool perm_gate, LAS float* scr, int gw, int NGW, int lane) {
    const int nblk = N / 32, nitems = (K / 64) * nblk; const rsrc_t wt_rs = mk_rsrc(WT, (size_t)N * ldk * 2);
    float cur[32], nxt[32]; f32x4 gc0, gc1, gn0, gn1;
#define CONV_LOAD(dst, g0_, g1_, it) do { const int kb_ = (it) / nblk, nb_ = (it) % nblk; const float* wp_ = W + (size_t)(64 * kb_ + (lane >> 5)) * N + 32 * nb_ + (lane & 31); \
        _Pragma("unroll") for (int i = 0; i < 32; ++i) dst[i] = wp_[(size_t)(2 * i) * N]; \
        g0_ = *(const f32x4*)(g + 64 * kb_ + 8 * (lane & 7)); g1_ = *(const f32x4*)(g + 64 * kb_ + 8 * (lane & 7) + 4); } while (0)
    int item = gw;
    if (item < nitems) CONV_LOAD(cur, gc0, gc1, item);
    while (item < nitems) {
        const int next = item + NGW;
        if (next < nitems) CONV_LOAD(nxt, gn0, gn1, next);
        const int kb = item / nblk, nb = item % nblk, k0 = 64 * kb, n0 = 32 * nb;
        int nd = n0;
        if (perm_gate && n0 >= NQKV) { const int c = n0 - NQKV; nd = c < 1024 ? NQKV + 256 * (c >> 7) + (c & 127) : NQKV + 256 * ((c - 1024) >> 7) + 128 + ((c - 1024) & 127); }
#pragma unroll
        for (int i = 0; i < 32; ++i) scr[(2 * i + (lane >> 5)) * 33 + (lane & 31)] = cur[i];
        asm volatile("s_waitcnt lgkmcnt(0)" ::: "memory");
        const int c = lane & 7;
#pragma unroll
        for (int j = 0; j < 4; ++j) { const int n = (lane >> 3) + 8 * j; const LAS float* s = scr + (8 * c) * 33 + n;
            u32x4 o; o.x = cvtpk(s[0 * 33] * gc0[0], s[1 * 33] * gc0[1]); o.y = cvtpk(s[2 * 33] * gc0[2], s[3 * 33] * gc0[3]); o.z = cvtpk(s[4 * 33] * gc1[0], s[5 * 33] * gc1[1]); o.w = cvtpk(s[6 * 33] * gc1[2], s[7 * 33] * gc1[3]);
            st16(wt_rs, ((size_t)(nd + n) * ldk + koff + k0 + 8 * c) * 2, o); }
        asm volatile("s_waitcnt lgkmcnt(0)" ::: "memory");
#pragma unroll
        for (int i = 0; i < 32; ++i) cur[i] = nxt[i];
        gc0 = gn0; gc1 = gn1;
        item = next;
    }
#undef CONV_LOAD
}
DI void rownorm_rows(const float* x, bf16* XB, float* SS, int gw, int NGW, int lane) {
    for (int row = gw; row < M; row += 2 * NGW) {
        const int row2 = row + NGW < M ? row + NGW : row;
        const f32x4* xa = (const f32x4*)(x + (size_t)row * D) + lane; const f32x4* xb = (const f32x4*)(x + (size_t)row2 * D) + lane;
        f32x4 va[4], vb[4];
#pragma unroll
        for (int j = 0; j < 4; ++j) { va[j] = xa[64 * j]; vb[j] = xb[64 * j]; }
        u32x2* oa = (u32x2*)(XB + (size_t)row * D) + lane; u32x2* ob = (u32x2*)(XB + (size_t)row2 * D) + lane;
        float sa = 0.f, sb = 0.f;
#pragma unroll
        for (int j = 0; j < 4; ++j) { const f32x4 v = va[j], w = vb[j];
            sa += (v[0] * v[0] + v[1] * v[1]) + (v[2] * v[2] + v[3] * v[3]); sb += (w[0] * w[0] + w[1] * w[1]) + (w[2] * w[2] + w[3] * w[3]);
            u32x2 p; p.x = cvtpk(v[0], v[1]); p.y = cvtpk(v[2], v[3]); oa[64 * j] = p; u32x2 q; q.x = cvtpk(w[0], w[1]); q.y = cvtpk(w[2], w[3]); ob[64 * j] = q; }
        sa = wave_sum(sa); sb = wave_sum(sb);
        if (lane == 0) { *(f32x4*)(SS + (size_t)row * 4) = (f32x4){sa, 0.f, 0.f, 0.f}; *(f32x4*)(SS + (size_t)row2 * 4) = (f32x4){sb, 0.f, 0.f, 0.f}; }
    }
}
DI void final_rows(const bf16* xb, float* out, const float* SS, const float* gf, int gw, int NGW, int lane, bool dry) {
    const f32x4* g4 = (const f32x4*)gf + 2 * lane; const f32x4 ga0 = g4[0], ga1 = g4[1], gb0 = g4[128], gb1 = g4[129];
    for (int row = gw; row < M; row += 4 * NGW) {
        u32x4 xa[4], xb_[4]; f32x4 ss[4];
#pragma unroll
        for (int k = 0; k < 4; ++k) { const int r = row + k * NGW < M ? row + k * NGW : row; const u32x4* xr = (const u32x4*)(xb + (size_t)r * D) + lane; xa[k] = xr[0]; xb_[k] = xr[64]; ss[k] = *(const f32x4*)(SS + (size_t)r * 4); }
#pragma unroll
        for (int k = 0; k < 4; ++k) { const int r = row + k * NGW; if (r < M) { const float rr = rs_from(ss[k]); f32x4* orow = (f32x4*)(out + (size_t)r * D) + 2 * lane;
            f32x4 a, b, c, d2; unpack8(xa[k], a, b); unpack8(xb_[k], c, d2); a = (a * rr) * ga0; b = (b * rr) * ga1; c = (c * rr) * gb0; d2 = (d2 * rr) * gb1;
            if (!dry) { orow[0] = a; orow[1] = b; orow[128] = c; orow[129] = d2; } else asm volatile("" :: "v"(a), "v"(b), "v"(c), "v"(d2)); } }
    }
}
DI int t5_bucket(int d) {
    if (d < 16) return d;
    const int large = 16 + (int)(logf((float)d / 16.0f) / 2.0794415416798357f * 16.0f);
    return large < 31 ? large : 31;
}

#ifndef PROBE_TS
#define PROBE_TS -1
#endif
#ifndef MK_N_LAUNCHES
#define MK_N_LAUNCHES 1
#endif
constexpr int NPH = 16;
struct Args { const float* in[16]; float* out; unsigned char* ws; int ph_lo, ph_hi; };
static_assert(sizeof(Args) == 16 * 8 + 8 + 8 + 8, "Args has no padding");

typedef const __attribute__((address_space(4))) Args* KArgs;
struct PeOrder {
    int nM, nN, nwg, G, c, skip;
    DI void init(int M_, int N_, int G_, int c_, int skip_) { nM = M_ / 256; nN = N_ / 256; nwg = nM * nN; G = G_; c = c_; skip = skip_ < G_ ? skip_ : 0; }
    DI bool next(int i, pg8::Unit& u) const { if (c < skip) return false; const int L = i * (G - skip) + (c - skip); if (L >= nwg) return false; u.pm = L / nN; u.pn = L % nN; u.idx = i; return true; }
    DI void a_ready(const pg8::Unit&) const {}
    DI void done(const pg8::Unit&) const {}
};
DI KArgs kargs() { KArgs p = (KArgs)__builtin_amdgcn_kernarg_segment_ptr(); asm volatile("" : "+s"(p)); return p; }
struct Ctx { int tid, lane, wave, G, bx, vcu, gw, NGW; };
DI Ctx ctx(int wv) { Ctx c; int z = 0; asm volatile("" : "+v"(z)); const int ln = __builtin_amdgcn_mbcnt_hi(~0u, __builtin_amdgcn_mbcnt_lo(~0u, z)); int t = wv * 64 + ln; asm volatile("" : "+v"(t));
    int b = blockIdx.x; asm volatile("" : "+s"(b)); c.tid = t; c.lane = ln; c.wave = wv;
    c.G = gridDim.x; c.bx = b; c.vcu = (c.G % 8 == 0) ? (b % 8) * (c.G / 8) + b / 8 : b; c.gw = c.vcu * NWAVES + c.wave; c.NGW = c.G * NWAVES; return c; }
#define WSP(T, off) ((T*)(A->ws + (off)))
struct CJob { const float* W; const float* g; bf16* WT; int N, ldk, koff, it; };
DI CJob conv_resolve(int item, int l, KArgs A) {
    constexpr int I_UP = (512 / 64) * (D / 32), I_O = (D / 64) * (D / 32), I_F1 = (D / 64) * (FF / 32), I_F2 = (FF / 64) * (D / 32), I_PE = (PLE / 64) * (D / 32), I_PG = I_O;
    CJob j;
    if (item < I_F1) { j = CJob{A->in[6] + (size_t)l * D * FF, A->in[11] + l * D, WSP(bf16, WS_WFF1), FF, D, 0, item}; return j; } item -= I_F1;
    if (item < I_F2) { j = CJob{A->in[7] + (size_t)l * FF * D, nullptr, WSP(bf16, WS_WFF2), D, FF, 0, item}; return j; } item -= I_F2;
    if (item < I_UP) { j = CJob{A->in[3] + (size_t)l * 512 * D, nullptr, WSP(bf16, WS_WUP), D, D, 0, item}; return j; } item -= I_UP;
    if (item < I_UP) { j = CJob{A->in[4] + (size_t)l * 512 * D, nullptr, WSP(bf16, WS_WUP), D, D, 512, item}; return j; } item -= I_UP;
    if (item < I_O) { j = CJob{A->in[5] + (size_t)l * D * D, nullptr, WSP(bf16, WS_WO), D, D, 0, item}; return j; } item -= I_O;
    if (item < I_PG) { j = CJob{A->in[9] + (size_t)l * D * D, A->in[12] + l * D, WSP(bf16, WS_WPG), D, D, 0, item}; return j; } item -= I_PG;
    j = CJob{A->in[8] + (size_t)l * PLE * D, nullptr, WSP(bf16, WS_WPE), D, PLE, 0, item}; return j;
}
constexpr int CONV_LATER_ITEMS = 2 * (512 / 64) * (D / 32) + 2 * (D / 64) * (D / 32) + (D / 64) * (FF / 32) + (FF / 64) * (D / 32) + (PLE / 64) * (D / 32);
DI void conv_later(int l, KArgs A, LAS float* scr, int gw, int NGW, int lane) {
    for (int item = gw; item < CONV_LATER_ITEMS; item += NGW) {
        const CJob j = conv_resolve(item, l, A);
        const rsrc_t wt_rs = mk_rsrc(j.WT, (size_t)16 << 20);
        const int nblk = j.N / 32, kb = j.it / nblk, nb = j.it % nblk, k0 = 64 * kb, n0 = 32 * nb;
        const float* wp = j.W + (size_t)(k0 + (lane >> 5)) * j.N + n0 + (lane & 31);
        float cur[32];
#pragma unroll
        for (int i = 0; i < 32; ++i) cur[i] = wp[(size_t)(2 * i) * j.N];
        f32x4 g0, g1;
        if (j.g) { g0 = *(const f32x4*)(j.g + k0 + 8 * (lane & 7)); g1 = *(const f32x4*)(j.g + k0 + 8 * (lane & 7) + 4); }
#pragma unroll
        for (int i = 0; i < 32; ++i) scr[(2 * i + (lane >> 5)) * 33 + (lane & 31)] = cur[i];
        asm volatile("s_waitcnt lgkmcnt(0)" ::: "memory");
        const int c = lane & 7;
#pragma unroll
        for (int jj = 0; jj < 4; ++jj) { const int n = (lane >> 3) + 8 * jj; const LAS float* s = scr + (8 * c) * 33 + n;
            u32x4 o;
            if (j.g) { o.x = cvtpk(s[0 * 33] * g0[0], s[1 * 33] * g0[1]); o.y = cvtpk(s[2 * 33] * g0[2], s[3 * 33] * g0[3]); o.z = cvtpk(s[4 * 33] * g1[0], s[5 * 33] * g1[1]); o.w = cvtpk(s[6 * 33] * g1[2], s[7 * 33] * g1[3]); }
            else { o.x = cvtpk(s[0 * 33], s[1 * 33]); o.y = cvtpk(s[2 * 33], s[3 * 33]); o.z = cvtpk(s[4 * 33], s[5 * 33]); o.w = cvtpk(s[6 * 33], s[7 * 33]); }
            st16(wt_rs, ((size_t)(n0 + n) * j.ldk + j.koff + k0 + 8 * c) * 2, o); }
        asm volatile("s_waitcnt lgkmcnt(0)" ::: "memory");
    }
}
__global__ void __launch_bounds__(NWAVES * 64, 2) mk_fwd(Args args_unused) {
    extern __shared__ __attribute__((aligned(16))) unsigned char lds_raw[];
    LAS unsigned char* lds = (LAS unsigned char*)lds_raw;
    volatile LAS unsigned* MISC = (volatile LAS unsigned*)(lds + MISC_OFF);
    const int wv = __builtin_amdgcn_readfirstlane(threadIdx.x >> 6);
    for (int u = threadIdx.x; u < (LDS_BYTES - RING_BYTES) / 4; u += NWAVES * 64) ((LAS unsigned*)(lds + RING_BYTES))[u] = 0u;
    __syncthreads();
    int lo, hi;
    if (PROBE_TS >= 0 && blockIdx.x == 0 && threadIdx.x == 0) { KArgs A = kargs(); WSP(unsigned long long, WS_CTL + 32768)[31] = __builtin_amdgcn_s_memrealtime(); }
    XcdBarrier bar;
    { KArgs A = kargs(); lo = A->ph_lo; hi = A->ph_hi; bar.bar = WSP(unsigned, WS_CTL) + CW_BAR; bar.x = 0; bar.st = nullptr;
      if (MK_N_LAUNCHES == 1) bar = xcd_barrier_post(WSP(unsigned, WS_CTL) + CW_BAR, MISC + 8); }
#define IN(k) (lo <= (k) && (k) < hi)
#define STAMP(k) do { if (PROBE_TS >= 0 && blockIdx.x == 0) { const Ctx cs_ = ctx(wv); if (cs_.tid == 0) { KArgs A = kargs(); WSP(unsigned long long, WS_CTL + 32768)[(k)] = __builtin_amdgcn_s_memrealtime(); } } } while (0)
#ifndef PROBE_REP
#define PROBE_REP 0
#endif
#define REP_BEGIN(j) for (int rep_ = 0; rep_ <= ((PROBE_REP >> (j)) & 1); ++rep_) {
#define REP_END(j) if (rep_ < ((PROBE_REP >> (j)) & 1)) { XcdBarrier b_ = bar; asm volatile("" : "+s"(b_.bar)); const Ctx cb_ = ctx(wv); xcd_barrier(b_, cb_.tid == 0); } }
#define SEAM(k) do { if (IN(k) && IN((k) + 1)) { XcdBarrier b_ = bar; asm volatile("" : "+s"(b_.bar)); const Ctx cb_ = ctx(wv); xcd_barrier(b_, cb_.tid == 0); } STAMP(k); } while (0)
#define CONV(W, g, WT, K, N, ldk, koff, perm) conv_w((W), (g), (WT), (K), (N), (ldk), (koff), (perm), (LAS float*)(lds + c.wave * 16384), c.gw, c.NGW, c.lane)

    REP_BEGIN(7)
    if (IN(0)) {
        KArgs A = kargs(); const Ctx c = ctx(wv);
        float* BT = WSP(float, WS_BT);
        if (c.bx == 0) { const float* rel_bias = A->in[15]; const float* sinks = A->in[14];
            for (int i = c.tid; i < 8 * 128; i += NWAVES * 64) { const int h = i >> 7, d = i & 127; BT[i] = rel_bias[t5_bucket(d) * 8 + h] * LOG2E; }
            if (c.tid < 16) BT[1024 + c.tid] = sinks[c.tid] * LOG2E; }
        CONV(A->in[2], A->in[10], WSP(bf16, WS_WIN), D, NIN, D, 0, true);
        rownorm_rows(A->in[0], WSP(bf16, WS_XB), WSP(float, WS_SS), c.gw, c.NGW, c.lane);
        __syncthreads();
    }
    REP_END(7)
    SEAM(0);
#pragma unroll 1
    for (int l = 0; l < DEPTH; ++l) {
        const int pb = 1 + 7 * l;
#define SSA WSP(float, WS_SS + (l == 0 ? 0 : (size_t)M * 16))
#define SSB WSP(float, WS_SS + (l == 0 ? (size_t)M * 16 : 0))
        REP_BEGIN(0)
        if (IN(pb)) {
            KArgs A = kargs(); const Ctx c = ctx(wv);
            pg8::Gemm g{WSP(bf16, WS_XB), WSP(bf16, WS_WIN), M, NIN, D}; pg8::StaticOrder S; S.init(M, NIN, c.G, c.bx);
            rs_table_fill(lds, SSA, S, c.tid);
            EpiIn E{lds, mk_rsrc(WSP(bf16, WS_QKV), (size_t)M * NQKV * 2), mk_rsrc(WSP(bf16, WS_GATE), (size_t)M * NGATE * 2)};
            pg8::gemm_phase<EpiIn, pg8::StaticOrder, true, true>(lds, g, S, E, c.tid);
        }
        if (IN(pb)) {
            KArgs A = kargs(); const Ctx c = ctx(wv);
            const int skip = (c.G == 256) ? ((M / 256) * (NIN / 256)) % 256 : 0;
            if (c.bx >= skip && rep_ == ((PROBE_REP >> 0) & 1)) {
                const int gw2 = (c.bx - skip) * NWAVES + c.wave, NGW2 = (c.G - skip) * NWAVES; LAS float* scr = (LAS float*)(lds + c.wave * 16384);
                conv_later(l, A, scr, gw2, NGW2, c.lane);
                if (l == 0) { const float* p_in = A->in[1]; bf16* PB = WSP(bf16, WS_PB);
                    const size_t st_ = (size_t)(c.G - skip) * NWAVES * 64, n4_ = (size_t)DEPTH * M * PLE / 4;
                    size_t i = (size_t)(c.bx - skip) * (NWAVES * 64) + c.tid;
                    for (; i + 3 * st_ < n4_; i += 4 * st_) { f32x4 v[4];
#pragma unroll
                        for (int j = 0; j < 4; ++j) v[j] = ((const f32x4*)p_in)[i + j * st_];
#pragma unroll
                        for (int j = 0; j < 4; ++j) { u32x2 o; o.x = cvtpk(v[j][0], v[j][1]); o.y = cvtpk(v[j][2], v[j][3]); ((u32x2*)PB)[i + j * st_] = o; } }
                    for (; i < n4_; i += st_) { const f32x4 v = ((const f32x4*)p_in)[i]; u32x2 o; o.x = cvtpk(v[0], v[1]); o.y = cvtpk(v[2], v[3]); ((u32x2*)PB)[i] = o; } }
            }
            __syncthreads();
        }
        REP_END(0)
        SEAM(pb);
        REP_BEGIN(1)
        if (IN(pb + 1)) {
            KArgs A = kargs(); const Ctx c = ctx(wv);
            if (l == 0) { CONV(A->in[2] + (size_t)D * NIN, A->in[10] + D, WSP(bf16, WS_WIN), D, NIN, D, 0, true); __syncthreads(); }
            __syncthreads();
            { const rsrc_t att_rs = mk_rsrc(WSP(bf16, WS_ATT), (size_t)M * D * 2); LAS char* wl = (LAS char*)lds + c.wave * 16384;
              LAS float* btl = (LAS float*)(lds + RING_BYTES + 1024) + c.wave * 192; LAS float* wsf = btl + 128;
#ifndef PROBE_ATT
#define PROBE_ATT 0
#endif
              for (int ra_ = 0; ra_ <= (PROBE_ATT & 1); ++ra_)
              for (int u = c.gw; u < BATCH * 8 * (SEQ / 32); u += c.NGW) { const int bh = u >> 7, qb = u & 127; att::sbw_unit<true>(bh >> 3, bh & 7, qb, WSP(bf16, WS_QKV), att_rs, wl, c.lane); }
              for (int ra_ = 0; ra_ <= ((PROBE_ATT >> 1) & 1); ++ra_)
              for (int u = c.gw; u < BATCH * 8 * (SEQ / 32); u += c.NGW) { const int bh = u >> 7, qb = u & 127; att::swaw_unit(bh >> 3, bh & 7, qb, l, WSP(bf16, WS_QKV), WSP(float, WS_BT), att_rs, wl, btl, wsf, c.lane); } }
        }
        REP_END(1)
        SEAM(pb + 1);
        REP_BEGIN(2)
        if (IN(pb + 2)) {
            KArgs A = kargs(); const Ctx c = ctx(wv);
            pg8::Gemm g{WSP(bf16, WS_ATT), WSP(bf16, WS_WUP), M, D, D}; pg8::StaticOrder S; S.init(M, D, c.G, c.bx);
            EpiUp E{WSP(bf16, WS_GATE), mk_rsrc(WSP(bf16, WS_MRG), (size_t)M * D * 2)};
            pg8::gemm_phase<EpiUp, pg8::StaticOrder, true, true>(lds, g, S, E, c.tid);
        }
        REP_END(2)
        SEAM(pb + 2);
        for (int rep_ = 0; rep_ <= (l == 0 ? ((PROBE_REP >> 3) & 1) : 0); ++rep_) {
        if (IN(pb + 3)) {
            KArgs A = kargs(); const Ctx c = ctx(wv);
            if (c.G == 256) {
                pg8::Gemm g{WSP(bf16, WS_MRG), WSP(bf16, WS_WO), M, D, D}; pg8::StaticOrder S; S.init(M, D, c.G, c.bx);
                if (l == 0) { EpiRes<false, true> E{A->in[0], nullptr, mk_rsrc(WSP(bf16, WS_XB), (size_t)M * D * 2), SSB, nullptr, nullptr, false, bar};
                    pg8::gemm_phase<EpiRes<false, true>, pg8::StaticOrder, false, true>(lds, g, S, E, c.tid); }
                else { EpiRes<false, false> E{nullptr, WSP(bf16, WS_XB), mk_rsrc(WSP(bf16, WS_XB), (size_t)M * D * 2), SSB, nullptr, nullptr, false, bar};
                    pg8::gemm_phase<EpiRes<false, false>, pg8::StaticOrder, false, true>(lds, g, S, E, c.tid); }
            }
        }
        if (rep_ < (l == 0 ? ((PROBE_REP >> 3) & 1) : 0)) { XcdBarrier b_ = bar; asm volatile("" : "+s"(b_.bar)); const Ctx cb_ = ctx(wv); xcd_barrier(b_, cb_.tid == 0); } }
        SEAM(pb + 3);
        REP_BEGIN(4)
        if (IN(pb + 4)) {
            KArgs A = kargs(); const Ctx c = ctx(wv);
            { pg8::Gemm g{WSP(bf16, WS_XB), WSP(bf16, WS_WFF1), M, FF, D}; pg8::StaticOrder S; S.init(M, FF, c.G, c.bx);
              rs_table_fill(lds, SSB, S, c.tid);
              EpiFf1 E{lds, mk_rsrc(WSP(bf16, WS_U), (size_t)M * FF * 2)};
              pg8::gemm_phase<EpiFf1, pg8::StaticOrder, true, true>(lds, g, S, E, c.tid); }
        }
        if (IN(pb + 4)) {
            KArgs A = kargs(); const Ctx c = ctx(wv);
            { pg8::Gemm g{WSP(bf16, WS_PB) + (size_t)l * M * PLE, WSP(bf16, WS_WPE), M, D, PLE}; pg8::StaticOrder S; S.init(M, D, c.G, c.bx);
              EpiPe E{mk_rsrc(WSP(bf16, WS_PE), (size_t)M * D * 2)};
              pg8::gemm_phase<EpiPe, pg8::StaticOrder, true, true>(lds, g, S, E, c.tid); }
        }
        REP_END(4)
        SEAM(pb + 4);
        if (IN(pb + 5)) {
            KArgs A = kargs(); const Ctx c = ctx(wv);
            if (c.G == 256) {
                pg8::Gemm g{WSP(bf16, WS_U), WSP(bf16, WS_WFF2), M, D, FF}; pg8::StaticOrder S; S.init(M, D, c.G, c.bx);
                for (int rep_ = ((PROBE_REP >> 5) & 1); rep_ >= 0; --rep_) { EpiRes<false, false> E{nullptr, WSP(bf16, WS_XB), mk_rsrc(WSP(bf16, WS_XB), (size_t)M * D * 2), SSA, nullptr, nullptr, rep_ != 0, bar};
                pg8::gemm_phase<EpiRes<false, false>, pg8::StaticOrder, false, true>(lds, g, S, E, c.tid); }
            }
        }
        SEAM(pb + 5);
        if (IN(pb + 6)) {
            KArgs A = kargs(); const Ctx c = ctx(wv);
            if (c.G == 256) {
                pg8::Gemm g{WSP(bf16, WS_XB), WSP(bf16, WS_WPG), M, D, D}; pg8::StaticOrder S; S.init(M, D, c.G, c.bx);
                for (int rep_ = ((PROBE_REP >> 6) & 1); rep_ >= 0; --rep_) { XcdBarrier b_ = bar; asm volatile("" : "+s"(b_.bar)); EpiRes<true, false> E{nullptr, WSP(bf16, WS_XB), mk_rsrc(WSP(bf16, WS_XB), (size_t)M * D * 2), SSB, WSP(bf16, WS_PE), SSA, rep_ != 0, b_};
                pg8::gemm_phase<EpiRes<true, false>, pg8::StaticOrder, false, true>(lds, g, S, E, c.tid); }
            }
        }
        SEAM(pb + 6);
    }
#ifdef PROBE_XBAR
    for (int xb_ = 0; xb_ < PROBE_XBAR; ++xb_) { XcdBarrier b_ = bar; asm volatile("" : "+s"(b_.bar)); const Ctx cb_ = ctx(wv); xcd_barrier(b_, cb_.tid == 0); }
#endif
    if (IN(NPH - 1)) { KArgs A = kargs(); const Ctx c = ctx(wv); for (int rep_ = ((PROBE_REP >> 8) & 1); rep_ >= 0; --rep_) final_rows(WSP(bf16, WS_XB), A->out, WSP(float, WS_SS), A->in[13], c.gw, c.NGW, c.lane, rep_ != 0); }
    if (PROBE_TS >= 0) {
        __syncthreads(); KArgs A = kargs(); const Ctx c = ctx(wv); const unsigned long long* ts = WSP(unsigned long long, WS_CTL + 32768);
        const unsigned long long t1 = __hip_atomic_load(ts + PROBE_TS, __ATOMIC_RELAXED, __HIP_MEMORY_SCOPE_AGENT), t0 = __hip_atomic_load(ts + (PROBE_TS == 0 ? 31 : PROBE_TS - 1), __ATOMIC_RELAXED, __HIP_MEMORY_SCOPE_AGENT);
        const float V = (float)(t1 - t0) * (0.01f / 30.0f);
        for (size_t i = (size_t)c.vcu * (NWAVES * 64) + c.tid; i < (size_t)M * D / 4; i += (size_t)c.G * NWAVES * 64) ((f32x4*)A->out)[i] = (f32x4){V, V, V, V};
    }
#undef IN
#undef SEAM
#undef CONV
}

extern "C" void kernel_launch(void* const* d_in, const int* in_sizes, int n_in, void* d_out, int out_size, void* d_ws, size_t ws_size, hipStream_t stream) {
    static int grid = 0;
    if (grid == 0) {
        if (n_in != 16 || in_sizes[0] != M * D || out_size != M * D || ws_size < WS_END) { fprintf(stderr, "kernel_launch: unexpected shapes (n_in %d, in0 %d, out %d, ws %zu); nothing launched\n", n_in, n_in > 0 ? in_sizes[0] : -1, out_size, ws_size); grid = -1; return; }
        int dev = 0, cus = 0, per_cu = 0;
        if (hipGetDevice(&dev) != hipSuccess || hipDeviceGetAttribute(&cus, hipDeviceAttributeMultiprocessorCount, dev) != hipSuccess) { fprintf(stderr, "kernel_launch: device query failed\n"); grid = -1; return; }
        if (hipFuncSetAttribute((const void*)mk_fwd, hipFuncAttributeMaxDynamicSharedMemorySize, LDS_BYTES) != hipSuccess) { fprintf(stderr, "kernel_launch: hipFuncSetAttribute failed\n"); grid = -1; return; }
        if (hipOccupancyMaxActiveBlocksPerMultiprocessor(&per_cu, (const void*)mk_fwd, NWAVES * 64, LDS_BYTES) != hipSuccess || per_cu < 1) fprintf(stderr, "kernel_launch: note: occupancy query reports %d workgroups per CU\n", per_cu);
        (void)hipGetLastError();
        grid = cus;
        if (grid != 256) fprintf(stderr, "kernel_launch: %d CUs; the single-unit GEMM phases need exactly 256 workgroups\n", grid);
    }
    if (grid < 0) return;
    if (hipMemsetAsync((char*)d_ws + WS_CTL, 0, CTL_ZERO_BYTES, stream) != hipSuccess) { fprintf(stderr, "kernel_launch: memset failed\n"); return; }
    Args a{};
    for (int i = 0; i < 16; ++i) a.in[i] = (const float*)d_in[i];
    a.out = (float*)d_out; a.ws = (unsigned char*)d_ws;
    if (MK_N_LAUNCHES == 1) { a.ph_lo = 0; a.ph_hi = NPH; hipLaunchKernelGGL(mk_fwd, dim3(grid), dim3(NWAVES * 64), LDS_BYTES, stream, a); }
    else for (int li = 0; li < NPH; ++li) { a.ph_lo = li; a.ph_hi = li + 1; hipLaunchKernelGGL(mk_fwd, dim3(grid), dim3(NWAVES * 64), LDS_BYTES, stream, a); }
    const hipError_t le = hipPeekAtLastError();
    if (le != hipSuccess) fprintf(stderr, "kernel_launch: launch failed: %s\n", hipGetErrorName(le));
}
```
